# Optimizing an MI355X kernel written in HIP

```python
import math
import jax, jax.numpy as jnp
from jax import lax
import numpy as np

D_MODEL = 1024
BATCH = 4
SEQ = 8192
DEPTH = 4

N_MIXERS = 2
N_ATTN_LAYERS = (DEPTH + 1) // 2
N_POOL_LAYERS = DEPTH // 2
N_HEADS = 8
HEAD_DIM = D_MODEL // (2 * N_HEADS)
V_DIM = 2 * HEAD_DIM
QK_WIDTH = 2 * N_HEADS * HEAD_DIM
ROT_DIM = HEAD_DIM // 4
ROPE_THETA = 500000.0
Q_BLOCK = 128
SUBLN_EPS = 1e-5
POOL_WINDOWS = (2, 4, 8, 16)
N_POOL_GROUPS = len(POOL_WINDOWS)
POOL_GROUP_DIM = D_MODEL // N_POOL_GROUPS
N_GROUPS = 4
EXPERTS_PER_GROUP = 8
N_EXPERTS = N_GROUPS * EXPERTS_PER_GROUP
TOP_K = 2
D_EXPERT = D_MODEL // 2
MOE_BLOCK = 128
ROUTER_BIAS_SCALE = 0.01
DEEPNORM_ALPHA = (2 * DEPTH) ** 0.25
DEEPNORM_BETA = (8 * DEPTH) ** -0.25
LN_EPS = 1e-5

kernel_name = "hybrid_diffattn_pool_hiermoe_deepnorm"


def layer_norm(x, g, b):
    xf = x.astype(jnp.float32)
    mu = jnp.mean(xf, -1, keepdims=True)
    var = jnp.mean(jnp.square(xf - mu), -1, keepdims=True)
    return ((xf - mu) * lax.rsqrt(var + LN_EPS) * g + b).astype(x.dtype)


def rotary_tables(seq):
    inv = ROPE_THETA ** (-jnp.arange(0, ROT_DIM, 2, dtype=jnp.float32) / ROT_DIM)
    ang = jnp.arange(seq, dtype=jnp.float32)[:, None] * inv[None, :]
    return jnp.cos(ang), jnp.sin(ang)


def apply_partial_rope(t, cos, sin):
    half = ROT_DIM // 2
    shape = (1, cos.shape[0]) + (1,) * (t.ndim - 3) + (half,)
    c = cos.reshape(shape).astype(t.dtype)
    s = sin.reshape(shape).astype(t.dtype)
    r1, r2, rest = t[..., :half], t[..., half:ROT_DIM], t[..., ROT_DIM:]
    return jnp.concatenate([r1 * c - r2 * s, r1 * s + r2 * c, rest], axis=-1)


def diff_attention(x, w_qkv, w_o, lq1, lk1, lq2, lk2, sub_g, lambda_init, cos, sin):
    B, S, _ = x.shape
    qkv = x @ w_qkv
    q, k, v = jnp.split(qkv, [QK_WIDTH, 2 * QK_WIDTH], axis=-1)
    q = apply_partial_rope(q.reshape(B, S, N_HEADS, 2, HEAD_DIM), cos, sin)
    k = apply_partial_rope(k.reshape(B, S, N_HEADS, 2, HEAD_DIM), cos, sin)
    q = q.transpose(0, 2, 3, 1, 4)
    k = k.transpose(0, 2, 3, 1, 4)
    v = v.reshape(B, S, N_HEADS, V_DIM).transpose(0, 2, 1, 3)
    lam = (jnp.exp(jnp.sum(lq1 * lk1).astype(jnp.float32))
           - jnp.exp(jnp.sum(lq2 * lk2).astype(jnp.float32)) + lambda_init)
    scale = HEAD_DIM ** -0.5
    outs = []
    for blk in range(S // Q_BLOCK):
        lo, hi = blk * Q_BLOCK, (blk + 1) * Q_BLOCK
        qb = q[:, :, :, lo:hi]
        kb = k[:, :, :, :hi]
        vb = v[:, :, :hi]
        s = jnp.einsum('bhmqd,bhmkd->bhmqk', qb, kb).astype(jnp.float32) * scale
        mask = jnp.arange(lo, hi)[:, None] >= jnp.arange(hi)[None, :]
        p = jax.nn.softmax(jnp.where(mask, s, -jnp.inf), axis=-1)
        a = (p[:, :, 0] - lam * p[:, :, 1]).astype(v.dtype)
        outs.append(jnp.einsum('bhqk,bhkd->bhqd', a, vb))
    o = jnp.concatenate(outs, axis=2).astype(jnp.float32)
    o = o * lax.rsqrt(jnp.mean(jnp.square(o), -1, keepdims=True) + SUBLN_EPS) * sub_g
    o = (o * (1.0 - lambda_init)).astype(x.dtype)
    o = o.transpose(0, 2, 1, 3).reshape(B, S, N_HEADS * V_DIM)
    return o @ w_o


def pool_mixer(x, w_in, w_grp, ls, w_out):
    B, S, _ = x.shape
    u = (x @ w_in).reshape(B, S, N_POOL_GROUPS, POOL_GROUP_DIM)
    count = jnp.arange(1, S + 1, dtype=jnp.float32)
    feats = []
    for g, w in enumerate(POOL_WINDOWS):
        ug = u[:, :, g].astype(jnp.float32)
        cs = jnp.cumsum(ug, axis=1)
        lag = jnp.pad(cs[:, :S - w], ((0, 0), (w, 0), (0, 0)))
        mean = (cs - lag) / jnp.minimum(count, float(w))[None, :, None]
        feats.append(mean - ug)
    p = jnp.stack(feats, axis=2).astype(x.dtype)
    y = jnp.einsum('bsgc,gcd->bsgd', p, w_grp).reshape(B, S, D_MODEL) * ls
    return y @ w_out


def hier_moe(x, w_grp_router, b_grp_router, w_exp_router, b_exp_router, w_gate, w_up, w_down):
    B, S, D = x.shape
    N = B * S
    xf = x.reshape(N, D)
    g_logits = (xf @ w_grp_router + b_grp_router).astype(jnp.float32)
    g_idx = jnp.argmax(g_logits, axis=-1)
    g_p = jnp.take_along_axis(jax.nn.softmax(g_logits, -1), g_idx[:, None], -1)
    e_logits = (xf @ w_exp_router + b_exp_router).astype(jnp.float32)
    e_logits = e_logits.reshape(N, N_GROUPS, EXPERTS_PER_GROUP)
    e_in = jnp.take_along_axis(e_logits, g_idx[:, None, None], axis=1)[:, 0]
    top_v, top_i = lax.top_k(e_in, TOP_K)
    gate = g_p * jax.nn.softmax(top_v, axis=-1)
    expert_id = g_idx[:, None] * EXPERTS_PER_GROUP + top_i
    A = N * TOP_K
    eid = expert_id.reshape(A)
    tok = jnp.repeat(jnp.arange(N, dtype=jnp.int32), TOP_K)
    wts = gate.reshape(A)
    order = jnp.argsort(eid)
    eid_s, tok_s, w_s = eid[order], tok[order], wts[order]
    counts = jnp.bincount(eid, length=N_EXPERTS)
    starts = jnp.cumsum(counts) - counts
    padded = (counts + MOE_BLOCK - 1) // MOE_BLOCK * MOE_BLOCK
    pad_ends = jnp.cumsum(padded)
    pad_starts = pad_ends - padded
    dest = pad_starts[eid_s] + jnp.arange(A) - starts[eid_s]
    P = A + N_EXPERTS * MOE_BLOCK
    NB = P // MOE_BLOCK
    tok_pad = jnp.zeros((P,), jnp.int32).at[dest].set(tok_s)
    w_pad = jnp.zeros((P,), wts.dtype).at[dest].set(w_s)
    blk_e = jnp.minimum(jnp.searchsorted(pad_ends, jnp.arange(NB) * MOE_BLOCK, side='right'),
                        N_EXPERTS - 1)
    xin = xf[tok_pad].reshape(NB, MOE_BLOCK, D)

    def run_block(args):
        xb, e = args
        h = jax.nn.silu(xb @ w_gate[e]) * (xb @ w_up[e])
        return h @ w_down[e]

    y = lax.map(run_block, (xin, blk_e)).reshape(P, D)
    out = jnp.zeros((N, D), x.dtype).at[tok_pad].add(y * w_pad[:, None].astype(y.dtype))
    return out.reshape(B, S, D)


def setup_inputs(seed: int = 0) -> dict:
    key = jax.random.key(seed)
    ks = jax.random.split(key, 24)
    f32 = jnp.float32
    nrm = lambda k, shp, sc: jax.random.normal(k, shp, f32) * sc
    D = D_MODEL
    w_qk = nrm(ks[1], (N_ATTN_LAYERS, D, 2 * QK_WIDTH), D ** -0.5)
    w_v = nrm(ks[2], (N_ATTN_LAYERS, D, N_HEADS * V_DIM), D ** -0.5) * DEEPNORM_BETA
    return {
        "x": jax.random.normal(ks[0], (BATCH, SEQ, D), f32),
        "attn_w_qkv": jnp.concatenate([w_qk, w_v], axis=-1),
        "attn_w_o": nrm(ks[3], (N_ATTN_LAYERS, N_HEADS * V_DIM, D), (N_HEADS * V_DIM) ** -0.5) * DEEPNORM_BETA,
        "attn_lq1": nrm(ks[4], (N_ATTN_LAYERS, HEAD_DIM), 0.1),
        "attn_lk1": nrm(ks[5], (N_ATTN_LAYERS, HEAD_DIM), 0.1),
        "attn_lq2": nrm(ks[6], (N_ATTN_LAYERS, HEAD_DIM), 0.1),
        "attn_lk2": nrm(ks[7], (N_ATTN_LAYERS, HEAD_DIM), 0.1),
        "attn_sub_g": 1.0 + nrm(ks[8], (N_ATTN_LAYERS, V_DIM), 0.02),
        "pool_w_in": nrm(ks[9], (N_POOL_LAYERS, D, D), D ** -0.5),
        "pool_w_grp": nrm(ks[10], (N_POOL_LAYERS, N_POOL_GROUPS, POOL_GROUP_DIM, POOL_GROUP_DIM), POOL_GROUP_DIM ** -0.5),
        "pool_scale": 1.0 + nrm(ks[11], (N_POOL_LAYERS, D), 0.02),
        "pool_w_out": nrm(ks[12], (N_POOL_LAYERS, D, D), D ** -0.5) * DEEPNORM_BETA,
        "ln_g": 1.0 + nrm(ks[13], (DEPTH, 2, D), 0.02),
        "ln_b": nrm(ks[14], (DEPTH, 2, D), 0.02),
        "moe_w_grp_router": nrm(ks[15], (DEPTH, D, N_GROUPS), D ** -0.5),
        "moe_b_grp_router": nrm(ks[16], (DEPTH, N_GROUPS), ROUTER_BIAS_SCALE),
        "moe_w_exp_router": nrm(ks[17], (DEPTH, D, N_EXPERTS), D ** -0.5),
        "moe_b_exp_router": nrm(ks[18], (DEPTH, N_EXPERTS), ROUTER_BIAS_SCALE),
        "moe_w_gate": nrm(ks[19], (DEPTH, N_EXPERTS, D, D_EXPERT), D ** -0.5),
        "moe_w_up": nrm(ks[20], (DEPTH, N_EXPERTS, D, D_EXPERT), D ** -0.5),
        "moe_w_down": nrm(ks[21], (DEPTH, N_EXPERTS, D_EXPERT, D), D_EXPERT ** -0.5) * DEEPNORM_BETA,
    }


def reference(x, attn_w_qkv, attn_w_o, attn_lq1, attn_lk1, attn_lq2, attn_lk2, attn_sub_g,
              pool_w_in, pool_w_grp, pool_scale, pool_w_out, ln_g, ln_b,
              moe_w_grp_router, moe_b_grp_router, moe_w_exp_router, moe_b_exp_router,
              moe_w_gate, moe_w_up, moe_w_down):
    cos, sin = rotary_tables(x.shape[1])
    h = x
    for i in range(DEPTH):
        j = i // N_MIXERS
        if i % N_MIXERS == 0:
            lambda_init = 0.8 - 0.6 * math.exp(-0.3 * i)
            mix = diff_attention(h, attn_w_qkv[j], attn_w_o[j], attn_lq1[j], attn_lk1[j],
                                 attn_lq2[j], attn_lk2[j], attn_sub_g[j], lambda_init, cos, sin)
        else:
            mix = pool_mixer(h, pool_w_in[j], pool_w_grp[j], pool_scale[j], pool_w_out[j])
        h = layer_norm(DEEPNORM_ALPHA * h + mix, ln_g[i, 0], ln_b[i, 0])
        ffn = hier_moe(h, moe_w_grp_router[i], moe_b_grp_router[i], moe_w_exp_router[i],
                       moe_b_exp_router[i], moe_w_gate[i], moe_w_up[i], moe_w_down[i])
        h = layer_norm(DEEPNORM_ALPHA * h + ffn, ln_g[i, 1], ln_b[i, 1])
    return h
```

```cpp
#include <hip/hip_runtime.h>
#include <cstdio>
#include <cstdint>

constexpr int D = 1024, BATCH = 4, SEQ = 8192, NTOK = BATCH * SEQ, DEPTH = 4;
constexpr int NH = 8, HD = 64, VD = 128, QKVW = 3072;
constexpr int NE = 32, NG = 4, EPG = 8, DE = 512, NASG = NTOK * 2;
constexpr float ALPHA = 1.6817928305074290f;
constexpr float LN_EPS = 1e-5f, SUBLN_EPS = 1e-5f;
constexpr float QSCALE = 0.125f * 1.4426950408889634f;
constexpr int LIST_CAP = NTOK;

constexpr size_t MiB = 1u << 20;
constexpr size_t WS_CTL = 0, CTL_ZERO_BYTES = 1 * MiB;
constexpr size_t WS_ROPE = 1 * MiB, WS_RTW = 1 * MiB + 512 * 1024;
constexpr size_t WS_WQKV = 3 * MiB, WS_WO = 15 * MiB, WS_WIN = 19 * MiB, WS_WGRP = 23 * MiB, WS_WOUT = 24 * MiB;
constexpr size_t WS_WGU = 28 * MiB, WS_WD = 92 * MiB;
constexpr size_t WS_LTOK = 124 * MiB, WS_GATEW = 128 * MiB, WS_O0S = 129 * MiB;
constexpr size_t WS_HB = 162 * MiB, WS_Q = 226 * MiB, WS_K = 290 * MiB, WS_V = 354 * MiB, WS_O = 418 * MiB, WS_Y = 482 * MiB, WS_WGU2 = 610 * MiB, WS_WD2 = 674 * MiB, WS_END = 706 * MiB;
static_assert(WS_V - WS_K == WS_K - WS_Q, "Q|K|V equally spaced");
constexpr size_t WS_T = WS_Y;
constexpr size_t WS_STATS = WS_O0S + 16 * MiB;
constexpr size_t WS_ACT = WS_Q;
constexpr int CW_TMO = 0, CW_CODE = 1, CW_LAM = 512, CW_CNT = 1024  , CW_BAR = 8192;

typedef unsigned short bf16_t;
typedef float f32x4 __attribute__((ext_vector_type(4)));
typedef unsigned u32x4 __attribute__((ext_vector_type(4)));
typedef unsigned u32x2 __attribute__((ext_vector_type(2)));
#define LAS __attribute__((address_space(3)))

__device__ __forceinline__ float bf2f(bf16_t v) { return __uint_as_float((unsigned)v << 16); }
__device__ __forceinline__ unsigned f2bf(float f) { unsigned u = __float_as_uint(f); return (u + 0x7fffu + ((u >> 16) & 1u)) >> 16; }
__device__ __forceinline__ unsigned pk2(float lo, float hi) { return f2bf(lo) | (f2bf(hi) << 16); }
__device__ __forceinline__ unsigned cvt_pk_bf16(float lo, float hi) { typedef float f2 __attribute__((ext_vector_type(2))); typedef __bf16 b2 __attribute__((ext_vector_type(2))); f2 v = {lo, hi}; b2 b = __builtin_convertvector(v, b2); return __builtin_bit_cast(unsigned, b); }
__device__ __forceinline__ float wave_sum(float v) {
#pragma unroll
    for (int o = 1; o < 64; o <<= 1) v += __shfl_xor(v, o);
    return v;
}

struct Args {
    const float* in[21]; float* out; unsigned char* ws; int ph_lo, ph_hi;
};

namespace pg8 {
typedef short bf16x8 __attribute__((ext_vector_type(8)));
constexpr int BM = 256, BK = 64, HALF = 128, HTB = HALF * BK * 2, STAGE_BYTES = 8 * HTB, NXCD = 8, WGM = 8;
__device__ __forceinline__ int lds_byte(int r, int c) { const int st = (r >> 4) * 2 + (c >> 5), rr = r & 15, cc = c & 31, ob = rr * 64 + cc * 2; return st * 1024 + (ob ^ (((ob >> 9) & 1) << 5)); }
__device__ __forceinline__ void stage_rc(int b, int& R, int& C) { const int st = b / 1024, sb = b % 1024, swz = sb ^ (((sb >> 9) & 1) << 5); R = (st >> 1) * 16 + swz / 64; C = (st & 1) * 32 + (swz % 64) / 2; }
__device__ __forceinline__ int perm32(int rho) { const int n = rho >> 4, i = rho & 15; return 8 * (i >> 2) + 4 * n + (i & 3); }
struct Unit { int pm, pn, pnb, e, pos0, cnt, slot; };
struct Gemm { const bf16_t* A; const bf16_t* Bt; int lda, ldb, K, acol; };

struct StaticOrder {
    int nM, nN, nwg, G, c;
    __device__ void init(int M, int N, int G_, int c_) { nM = M / BM; nN = N / BM; nwg = nM * nN; G = G_; c = c_; }
    __device__ bool next(int i, Unit& u) const {
        const long L = (long)i * G + c; if (L >= nwg) return false;
        int wgid = (int)L; { const int q = nwg / NXCD, r = nwg % NXCD, xcd = wgid % NXCD, off = wgid / NXCD; wgid = (xcd < r ? xcd * (q + 1) : r * (q + 1) + (xcd - r) * q) + off; }
        const int nig = WGM * nN, gid = wgid / nig, fm = gid * WGM, gsz = (nM - fm) < WGM ? (nM - fm) : WGM;
        u.pm = fm + ((wgid % nig) % gsz); u.pn = (wgid % nig) / gsz; u.pnb = u.pn; u.e = 0; u.pos0 = 0; u.cnt = 0; u.slot = 0; return true;
    }
    __device__ __forceinline__ unsigned row_off(const Unit&, int) const { return 0u; }
};
struct MoeOrder {
    const LAS int* tstart; const LAS int* cntl; const LAS unsigned* tokoff; const LAS int* ue;
    int ntiles, G, c, ilo, ihi;
    __device__ bool find(int i, Unit& u) const {
        const int L = i * G + c; if (L >= ntiles * 4) return false;
        const int rt = (int)(L >> 2); u.pn = (int)(L & 3);
        int e = 0;
        for (int j = 1; j < NE; ++j) if (tstart[j] <= rt) e = j;
        u.e = e; u.pos0 = (rt - tstart[e]) * 256; u.cnt = cntl[e]; u.pm = rt; u.pnb = e * 4 + u.pn; u.slot = i; return true;
    }
    __device__ bool next(int i0, Unit& u) const {
        const int i = i0 + ilo; if (i >= ihi) return false;
        const int L = i * G + c; if (L >= ntiles * 4) return false;
        const int rt = L >> 2, e = ue[i]; u.pn = L & 3;
        u.e = e; u.pos0 = (rt - tstart[e]) * 256; u.cnt = cntl[e]; u.pm = rt; u.pnb = e * 4 + u.pn; u.slot = i; return true;
    }
    __device__ __forceinline__ unsigned row_off(const Unit& u, int row) const { return tokoff[u.slot * 256 + row]; }
};

typedef const f32x4 (&AccRef)[2][2][4][2];
struct EpiQKV {
    static constexpr bool PERM = true;
    bf16_t* Q; const float* rc; const float* rs;
    __device__ __forceinline__ void operator()(AccRef acc, const Unit& u, int wr, int wc, int fr, int fq) const {
        const int reg = u.pn >> 2; bf16_t* base = Q + (size_t)reg * ((WS_K - WS_Q) / 2);
        const int row0 = u.pm * BM + wr * 64 + fr, col0 = (u.pn & 3) * BM + wc * 32 + 8 * fq;
        const bool rope = (reg < 2) && ((wc & 1) == 0);
        const float sc = reg == 0 ? QSCALE : 1.f, sgn = fq == 0 ? -1.f : 1.f;
#pragma unroll
        for (int ai = 0; ai < 2; ++ai)
#pragma unroll
            for (int m = 0; m < 4; ++m) { const int row = row0 + ai * HALF + m * 16;
                f32x4 c0 = (f32x4){1.f, 1.f, 1.f, 1.f}, c1 = c0, s0 = (f32x4){0.f, 0.f, 0.f, 0.f}, s1 = s0;
                if (rope) { const int pos = row & (SEQ - 1); c0 = *(const f32x4*)(rc + pos * 8); c1 = *(const f32x4*)(rc + pos * 8 + 4); s0 = *(const f32x4*)(rs + pos * 8); s1 = *(const f32x4*)(rs + pos * 8 + 4); }
                const int bb = row >> 13, tile = (row & (SEQ - 1)) >> 6, r = row & 63;
#pragma unroll
                for (int bj = 0; bj < 2; ++bj) { f32x4 v0 = acc[ai][bj][m][0], v1 = acc[ai][bj][m][1];
                    if (rope) { f32x4 p0, p1;
#pragma unroll
                        for (int q = 0; q < 4; ++q) { p0[q] = __shfl_xor(v0[q], 16); p1[q] = __shfl_xor(v1[q], 16); }
                        const f32x4 r0 = v0 * c0 + p0 * s0 * sgn, r1 = v1 * c1 + p1 * s1 * sgn;
                        if (fq < 2) { v0 = r0; v1 = r1; } }
                    v0 = v0 * sc; v1 = v1 * sc;
                    u32x4 w; w.x = pk2(v0[0], v0[1]); w.y = pk2(v0[2], v0[3]); w.z = pk2(v1[0], v1[1]); w.w = pk2(v1[2], v1[3]);
                    const int col = col0 + bj * HALF;
                    size_t off;
                    if (reg == 0) off = (size_t)row * D + col;
                    else if (reg == 1) off = ((((size_t)(bb * NH + (col >> 7)) * 2 + ((col >> 6) & 1)) * (SEQ / 64) + tile) * 64 + r) * 64 + ((((col & 63) >> 3) ^ ((r >> 1) & 7)) << 3);
                    else off = ((((size_t)(bb * NH + (col >> 7)) * (SEQ / 64) + tile) * 4 + ((col & 127) >> 5)) * 4 + (r >> 4)) * 512 + (r & 15) * 32 + (col & 31);
                    *(u32x4*)(base + off) = w; } }
    }
};
struct EpiResid {
    static constexpr bool PERM = true;
    const float* HinF; const bf16_t* HinB; bf16_t* out; float* stats;
    typedef __attribute__((address_space(1))) const f32x4 gcf4; typedef __attribute__((address_space(1))) const u32x4 gcu4;
    typedef __attribute__((address_space(1))) u32x4 gu4; typedef float f32x2_t __attribute__((ext_vector_type(2))); typedef __attribute__((address_space(1))) f32x2_t gf2;
    __device__ __forceinline__ void operator()(AccRef acc, const Unit& u, int wr, int wc, int fr, int fq) const {
        const int row0 = u.pm * BM + wr * 64 + fr, col0 = u.pn * BM + wc * 32 + 8 * fq;
#pragma unroll
        for (int ai = 0; ai < 2; ++ai) {
            f32x4 hv[4][2][2];
            if (HinF) {
#pragma unroll
                for (int m = 0; m < 4; ++m)
#pragma unroll
                    for (int bj = 0; bj < 2; ++bj)
#pragma unroll
                        for (int n = 0; n < 2; ++n) hv[m][bj][n] = *(gcf4*)(HinF + (size_t)(row0 + ai * HALF + m * 16) * D + col0 + bj * HALF + n * 4);
            } else {
                u32x4 hw[4][2];
#pragma unroll
                for (int m = 0; m < 4; ++m)
#pragma unroll
                    for (int bj = 0; bj < 2; ++bj) hw[m][bj] = *(gcu4*)(HinB + (size_t)(row0 + ai * HALF + m * 16) * D + col0 + bj * HALF);
#pragma unroll
                for (int m = 0; m < 4; ++m)
#pragma unroll
                    for (int bj = 0; bj < 2; ++bj) { const u32x4 w = hw[m][bj];
                        hv[m][bj][0] = (f32x4){__uint_as_float(w.x << 16), __uint_as_float(w.x & 0xffff0000u), __uint_as_float(w.y << 16), __uint_as_float(w.y & 0xffff0000u)};
                        hv[m][bj][1] = (f32x4){__uint_as_float(w.z << 16), __uint_as_float(w.z & 0xffff0000u), __uint_as_float(w.w << 16), __uint_as_float(w.w & 0xffff0000u)}; }
            }
            float ps[4], pq[4];
#pragma unroll
            for (int m = 0; m < 4; ++m) { const size_t off = (size_t)(row0 + ai * HALF + m * 16) * D + col0; ps[m] = 0.f; pq[m] = 0.f;
#pragma unroll
                for (int bj = 0; bj < 2; ++bj) { const f32x4 t0 = hv[m][bj][0] * ALPHA + acc[ai][bj][m][0], t1 = hv[m][bj][1] * ALPHA + acc[ai][bj][m][1];
                    u32x4 w; w.x = cvt_pk_bf16(t0.x, t0.y); w.y = cvt_pk_bf16(t0.z, t0.w); w.z = cvt_pk_bf16(t1.x, t1.y); w.w = cvt_pk_bf16(t1.z, t1.w);
                    *(gu4*)(out + off + bj * HALF) = w;
                    ps[m] += ((t0.x + t0.y) + (t0.z + t0.w)) + ((t1.x + t1.y) + (t1.z + t1.w));
                    pq[m] += ((t0.x * t0.x + t0.y * t0.y) + (t0.z * t0.z + t0.w * t0.w)) + ((t1.x * t1.x + t1.y * t1.y) + (t1.z * t1.z + t1.w * t1.w)); } }
#pragma unroll
            for (int m = 0; m < 4; ++m) { ps[m] += __shfl_xor(ps[m], 16); pq[m] += __shfl_xor(pq[m], 16); }
#pragma unroll
            for (int m = 0; m < 4; ++m) { ps[m] += __shfl_xor(ps[m], 32); pq[m] += __shfl_xor(pq[m], 32); }
            if (fq == 0) {
#pragma unroll
                for (int m = 0; m < 4; ++m) *(gf2*)(stats + ((size_t)(row0 + ai * HALF + m * 16) * 16 + u.pn * 4 + wc) * 2) = (f32x2_t){ps[m], pq[m]}; }
        }
    }
};
struct EpiBf16S {
    static constexpr bool PERM = true;
    bf16_t* O; const float* ls;
    __device__ __forceinline__ void operator()(AccRef acc, const Unit& u, int wr, int wc, int fr, int fq) const {
        const int row0 = u.pm * BM + wr * 64 + fr, col0 = u.pn * BM + wc * 32 + 8 * fq;
        f32x4 sv[2][2];
#pragma unroll
        for (int bj = 0; bj < 2; ++bj)
#pragma unroll
            for (int n = 0; n < 2; ++n) sv[bj][n] = ls ? *(const f32x4*)(ls + col0 + bj * HALF + 4 * n) : (f32x4){1.f, 1.f, 1.f, 1.f};
#pragma unroll
        for (int ai = 0; ai < 2; ++ai)
#pragma unroll
            for (int m = 0; m < 4; ++m)
#pragma unroll
                for (int bj = 0; bj < 2; ++bj) { const f32x4 v0 = acc[ai][bj][m][0] * sv[bj][0], v1 = acc[ai][bj][m][1] * sv[bj][1];
                    u32x4 w; w.x = pk2(v0[0], v0[1]); w.y = pk2(v0[2], v0[3]); w.z = pk2(v1[0], v1[1]); w.w = pk2(v1[2], v1[3]);
                    *(u32x4*)(O + (size_t)(row0 + ai * HALF + m * 16) * D + col0 + bj * HALF) = w; }
    }
};
__device__ __forceinline__ float silu_mul(float g, float u) { return g * __builtin_amdgcn_rcpf(1.f + __expf(-g)) * u; }
struct EpiSwiGLU {
    static constexpr bool PERM = true;
    bf16_t* ACT;
    __device__ __forceinline__ void operator()(AccRef acc, const Unit& u, int wr, int wc, int fr, int fq) const {
        const int row0 = u.pm * BM + wr * 64 + fr, col0 = u.pn * HALF + wc * 32 + 8 * fq;
#pragma unroll
        for (int ai = 0; ai < 2; ++ai)
#pragma unroll
            for (int m = 0; m < 4; ++m) { const f32x4 g0 = acc[ai][0][m][0], g1 = acc[ai][0][m][1], u0 = acc[ai][1][m][0], u1 = acc[ai][1][m][1];
                u32x4 w; w.x = pk2(silu_mul(g0[0], u0[0]), silu_mul(g0[1], u0[1])); w.y = pk2(silu_mul(g0[2], u0[2]), silu_mul(g0[3], u0[3]));
                w.z = pk2(silu_mul(g1[0], u1[0]), silu_mul(g1[1], u1[1])); w.w = pk2(silu_mul(g1[2], u1[2]), silu_mul(g1[3], u1[3]));
                *(u32x4*)(ACT + (size_t)(row0 + ai * HALF + m * 16) * DE + col0) = w; }
    }
};
struct EpiScatter {
    static constexpr bool PERM = true;
    bf16_t* Y; const LAS int* destl; const LAS float* gwl;
    __device__ __forceinline__ void operator()(AccRef acc, const Unit& u, int wr, int wc, int fr, int fq) const {
        const int col0 = u.pn * BM + wc * 32 + 8 * fq;
#pragma unroll
        for (int ai = 0; ai < 2; ++ai)
#pragma unroll
            for (int m = 0; m < 4; ++m) { const int pl = ai * HALF + wr * 64 + m * 16 + fr; const int dest = destl[u.slot * 256 + pl]; const float gw = gwl[u.slot * 256 + pl];
                if (dest >= 0) {
#pragma unroll
                    for (int bj = 0; bj < 2; ++bj) { const f32x4 v0 = acc[ai][bj][m][0] * gw, v1 = acc[ai][bj][m][1] * gw;
                        u32x4 w; w.x = pk2(v0[0], v0[1]); w.y = pk2(v0[2], v0[3]); w.z = pk2(v1[0], v1[1]); w.w = pk2(v1[2], v1[3]);
                        *(u32x4*)(Y + (size_t)dest * D + col0 + bj * HALF) = w; } } }
    }
};

template <class Epi, class Sched, bool ALIGN_EPI, bool GATHER>
__device__ __forceinline__ void gemm_phase(LAS unsigned char* lds, const Gemm g, const Sched& S, const Epi& E, int tid) {
    asm volatile("" : "+v"(tid));
    const int wid = __builtin_amdgcn_readfirstlane(tid >> 6), lane = tid & 63, wr = wid >> 2, wc = wid & 3, fr = lane & 15, fq = lane >> 4;
    const int K = g.K, nt = K / BK;
    int Rr[2], Cc[2]; unsigned voffB[2];
#pragma unroll
    for (int i = 0; i < 2; ++i) { int R, C; stage_rc(tid * 16 + i * 8192, R, C); Rr[i] = R; Cc[i] = C; const int Rb = Epi::PERM ? ((R & ~31) + perm32(R & 31)) : R; voffB[i] = (unsigned)(Rb * g.ldb + C) * 2u; }
    const size_t kstep = (size_t)(BK * 2);
    const size_t hstepB = (size_t)HALF * g.ldb * 2;
    const unsigned hstepA = (unsigned)HALF * (unsigned)g.lda * 2u;
    const unsigned ldsw = (unsigned)wid * 1024u;
    const int aoff = lds_byte(wr * 64 + fr, fq * 8), boff = lds_byte(wc * 32 + fr, fq * 8);
    unsigned cvo[2][2], nvo[2][2];
#define PG8_SETVO(vo, u) do { _Pragma("unroll") for (int _h = 0; _h < 2; ++_h) _Pragma("unroll") for (int _i = 0; _i < 2; ++_i) \
        vo[_h][_i] = GATHER ? (S.row_off(u, Rr[_i] + HALF * _h) + (unsigned)Cc[_i] * 2u) : ((unsigned)(Rr[_i] * g.lda + Cc[_i]) * 2u + (unsigned)_h * hstepA); } while (0)
#define PG8_UA(u) (GATHER ? (const char*)g.A : (const char*)g.A + ((size_t)(u).pm * BM * g.lda + (size_t)(u).pn * g.acol) * 2)
#define PG8_UB(u) ((const char*)g.Bt + (size_t)(u).pnb * BM * g.ldb * 2)
#define PG8_SA(b, h) (((b) * 2 + (h)) * HTB)
#define PG8_SB(b, h) ((4 + (b) * 2 + (h)) * HTB)
#define PG8_STB(bufoff, gbase) do { _Pragma("unroll") for (int _i = 0; _i < 2; ++_i) \
        __builtin_amdgcn_global_load_lds((const unsigned*)((const char*)(gbase) + voffB[_i]), (LAS unsigned*)(lds + (bufoff) + ldsw + _i * 8192), 16, 0, 0); } while (0)
#define PG8_STA(bufoff, gbase, H, NX) do { _Pragma("unroll") for (int _i = 0; _i < 2; ++_i) { const unsigned _o = (GATHER && (NX)) ? nvo[H][_i] : cvo[H][_i]; \
        __builtin_amdgcn_global_load_lds((const unsigned*)((const char*)(gbase) + _o), (LAS unsigned*)(lds + (bufoff) + ldsw + _i * 8192), 16, 0, 0); } } while (0)
#define PG8_LDA(dst, b, h) do { _Pragma("unroll") for (int m = 0; m < 4; ++m) _Pragma("unroll") for (int k = 0; k < 2; ++k) dst[m][k] = *(const LAS bf16x8*)(lds + PG8_SA(b, h) + aoff + m * 2048 + k * 1024); } while (0)
#define PG8_LDB(dst, b, h) do { _Pragma("unroll") for (int n = 0; n < 2; ++n) _Pragma("unroll") for (int k = 0; k < 2; ++k) dst[n][k] = *(const LAS bf16x8*)(lds + PG8_SB(b, h) + boff + n * 2048 + k * 1024); } while (0)
#define PG8_MMA(ai, bj, At, Bt) do { __builtin_amdgcn_s_setprio(1); _Pragma("unroll") for (int m = 0; m < 4; ++m) _Pragma("unroll") for (int n = 0; n < 2; ++n) _Pragma("unroll") for (int k = 0; k < 2; ++k) \
        acc[ai][bj][m][n] = __builtin_amdgcn_mfma_f32_16x16x32_bf16(Bt[n][k], At[m][k], acc[ai][bj][m][n], 0, 0, 0); __builtin_amdgcn_s_setprio(0); } while (0)
#define PG8_WAIT_V(n) asm volatile("s_waitcnt vmcnt(" #n ")" ::: "memory")
#define PG8_WAIT_L(n) asm volatile("s_waitcnt lgkmcnt(" #n ")" ::: "memory")
#define PG8_BAR __builtin_amdgcn_s_barrier()
#define PG8_SCHED __builtin_amdgcn_sched_barrier(0)
    Unit cur, nxt; int ui = 0;
    if (!S.next(0, cur)) return;
    f32x4 acc[2][2][4][2];
#pragma unroll
    for (int a = 0; a < 2; ++a)
#pragma unroll
        for (int b = 0; b < 2; ++b)
#pragma unroll
            for (int m = 0; m < 4; ++m)
#pragma unroll
                for (int n = 0; n < 2; ++n) acc[a][b][m][n] = (f32x4){0.f, 0.f, 0.f, 0.f};
    bf16x8 At[4][2], B0[2][2], B1[2][2];
    const char* cA = PG8_UA(cur); const char* cB = PG8_UB(cur);
    PG8_SETVO(cvo, cur);
#pragma unroll
    for (int _h = 0; _h < 2; ++_h)
#pragma unroll
        for (int _i = 0; _i < 2; ++_i) nvo[_h][_i] = cvo[_h][_i];
    PG8_STB(PG8_SB(0, 0), cB); PG8_STB(PG8_SB(0, 1), cB + hstepB); PG8_STA(PG8_SA(0, 0), cA, 0, false); PG8_STA(PG8_SA(0, 1), cA, 1, false);
    if (wr == 1) PG8_BAR;
    PG8_WAIT_V(2); PG8_BAR;
    PG8_STB(PG8_SB(1, 0), cB + kstep); PG8_STA(PG8_SA(1, 0), cA + kstep, 0, false); PG8_STB(PG8_SB(1, 1), cB + hstepB + kstep);
    PG8_WAIT_V(6); PG8_BAR;
    for (;;) {
        const bool has_next = S.next(ui + 1, nxt);
        const char* nA = has_next ? PG8_UA(nxt) : cA; const char* nB = has_next ? PG8_UB(nxt) : cB;
        if (GATHER) { if (has_next) { PG8_SETVO(nvo, nxt); } }
        for (int t = 0; t < nt; t += 2) {
            const bool last = (t == nt - 2);
            const char* a1 = cA + (size_t)(t + 1) * kstep;
            const char* a2 = last ? nA : cA + (size_t)(t + 2) * kstep; const char* b2 = last ? nB : cB + (size_t)(t + 2) * kstep;
            const char* a3 = a2 + kstep; const char* b3 = b2 + kstep;
            PG8_LDB(B0, 0, 0); PG8_LDB(B1, 0, 1); PG8_SCHED; PG8_LDA(At, 0, 0); PG8_STA(PG8_SA(1, 1), a1, 1, false);
            PG8_WAIT_V(8); PG8_WAIT_L(0); PG8_BAR; PG8_MMA(0, 0, At, B0); PG8_MMA(0, 1, At, B1); PG8_BAR; PG8_SCHED;
            PG8_LDA(At, 0, 1); PG8_STB(PG8_SB(0, 0), b2); PG8_STB(PG8_SB(0, 1), b2 + hstepB); PG8_STA(PG8_SA(0, 0), a2, 0, last);
            PG8_WAIT_V(8); PG8_WAIT_L(0); PG8_BAR; PG8_MMA(1, 0, At, B0); PG8_MMA(1, 1, At, B1); PG8_BAR; PG8_SCHED;
            PG8_LDB(B0, 1, 0); PG8_LDB(B1, 1, 1); PG8_SCHED; PG8_LDA(At, 1, 0); PG8_STA(PG8_SA(0, 1), a2, 1, last);
            PG8_WAIT_V(8); PG8_WAIT_L(0); PG8_BAR; PG8_MMA(0, 0, At, B0); PG8_MMA(0, 1, At, B1); PG8_BAR; PG8_SCHED;
            PG8_LDA(At, 1, 1); PG8_STB(PG8_SB(1, 0), b3); PG8_STB(PG8_SB(1, 1), b3 + hstepB); PG8_STA(PG8_SA(1, 0), a3, 0, last);
            PG8_WAIT_V(8); PG8_WAIT_L(0); PG8_BAR; PG8_MMA(1, 0, At, B0); PG8_MMA(1, 1, At, B1); PG8_BAR; PG8_SCHED;
        }
        if constexpr (ALIGN_EPI) { if (wr == 0) PG8_BAR; }
        E(acc, cur, wr, wc, fr, fq);
        if (!has_next) break;
#pragma unroll
        for (int a = 0; a < 2; ++a)
#pragma unroll
            for (int b = 0; b < 2; ++b)
#pragma unroll
                for (int m = 0; m < 4; ++m)
#pragma unroll
                    for (int n = 0; n < 2; ++n) acc[a][b][m][n] = (f32x4){0.f, 0.f, 0.f, 0.f};
        cur = nxt; cA = nA; cB = nB; ++ui;
#pragma unroll
        for (int _h = 0; _h < 2; ++_h)
#pragma unroll
            for (int _i = 0; _i < 2; ++_i) cvo[_h][_i] = nvo[_h][_i];
        if constexpr (ALIGN_EPI) { if (wr == 1) PG8_BAR; }
    }
    PG8_WAIT_V(0);
    if constexpr (!ALIGN_EPI) { if (wr == 0) PG8_BAR; }
    PG8_BAR;
#undef PG8_SETVO
#undef PG8_UA
#undef PG8_UB
#undef PG8_SA
#undef PG8_SB
#undef PG8_STA
#undef PG8_STB
#undef PG8_LDA
#undef PG8_LDB
#undef PG8_MMA
#undef PG8_WAIT_V
#undef PG8_WAIT_L
#undef PG8_BAR
#undef PG8_SCHED
}
}

namespace att {
typedef short bf16x8 __attribute__((ext_vector_type(8)));
typedef short s16x4 __attribute__((ext_vector_type(4)));
typedef float f32x16 __attribute__((ext_vector_type(16)));
constexpr int KSLOT = 8192, VSLOT = 16384, NSLOT = 3;
constexpr float BIGP = 1048576.f;
constexpr int L_K = 0, L_V = NSLOT * KSLOT, L_WS = L_V + NSLOT * VSLOT, L_Q = L_WS + 8 * 64 * 4, L_END = L_Q + 8 * 4096;
__device__ __forceinline__ int crow(int r, int hi) { return (r & 3) + 8 * (r >> 2) + 4 * hi; }
__device__ __forceinline__ s16x4 vtr(const LAS unsigned char* p) { typedef short v4i16_t __attribute__((ext_vector_type(4))); return __builtin_bit_cast(s16x4, __builtin_amdgcn_ds_read_tr16_b64_v4i16((LAS v4i16_t*)p)); }
__device__ __forceinline__ float swap_max(float m) { auto rr = __builtin_amdgcn_permlane32_swap(__float_as_uint(m), __float_as_uint(m), false, false); return fmaxf(__uint_as_float(rr[0]), __uint_as_float(rr[1])); }
__device__ __forceinline__ float swap_sum(float m) { auto rr = __builtin_amdgcn_permlane32_swap(__float_as_uint(m), __float_as_uint(m), false, false); return __uint_as_float(rr[0]) + __uint_as_float(rr[1]); }
__device__ __forceinline__ unsigned cvtpk(float lo, float hi) { typedef float f2 __attribute__((ext_vector_type(2))); typedef __bf16 b2 __attribute__((ext_vector_type(2))); f2 v = {lo, hi}; b2 b = __builtin_convertvector(v, b2); return __builtin_bit_cast(unsigned, b); }

__device__ __forceinline__ float max3f(float a, float b, float c) { float r; asm("v_max3_f32 %0, %1, %2, %3" : "=v"(r) : "v"(a), "v"(b), "v"(c)); return r; }
__device__ __forceinline__ void glds16(const char* sbase, unsigned voff, unsigned lds_dst) { unsigned keep;
    asm volatile("s_mov_b32 %0, m0\n\ts_mov_b32 m0, %3\n\ts_nop 0\n\tglobal_load_lds_dwordx4 %2, %1\n\ts_mov_b32 m0, %0" : "=&s"(keep) : "s"(sbase), "v"(voff), "s"(lds_dst) : "memory"); }
struct Tensors { const bf16_t* Q; const bf16_t* K; const bf16_t* V; bf16_t* O; float* o0s; const float* subg; float lam, oml; };

__device__ __forceinline__ void attn_unit(int b, int h, int qb, const Tensors& T, LAS unsigned char* lds, int tid, int bx) {
    const int lane = tid & 63, r32 = lane & 31, hi = lane >> 5, wid = __builtin_amdgcn_readfirstlane(tid >> 6);
    const size_t rowbase = (size_t)b * SEQ; const int q0 = qb * 256, NT = (q0 + 256) / 64;
    const int qrow = q0 + wid * 32 + r32, wave_qmin = q0 + wid * 32, wave_qmax = wave_qmin + 31;
    LAS float* wsf = (LAS float*)(lds + L_WS) + wid * 64;
    const unsigned lds0 = (unsigned)(uintptr_t)lds;
    const int kx = (r32 >> 1) & 7;
    const LAS unsigned char* kp0 = lds + L_K + r32 * 128 + ((hi ^ (kx & 1)) << 4) + ((kx >> 1) << 5);
    const LAS unsigned char* vp0 = lds + L_V + ((lane >> 4) & 1) * 32 + (lane & 3) * 8 + (4 * hi + ((lane & 15) >> 2)) * 64;
#define SB() __builtin_amdgcn_sched_barrier(0)
#define MF(a, b, c) __builtin_amdgcn_mfma_f32_32x32x16_bf16(a, b, c, 0, 0, 0)
    for (int map = 0; map < 2; ++map) {
        const char* qbase = (const char*)(T.Q + (rowbase + q0 + wid * 32) * D + h * 128 + map * 64);
        const char* kbase = (const char*)(T.K + ((size_t)((b * NH + h) * 2 + map) * (SEQ / 64)) * 4096 + wid * 512);
        const char* vbase = (const char*)(T.V + ((size_t)(b * NH + h) * (SEQ / 64)) * 8192 + wid * 512);
        const unsigned koff = (unsigned)lane * 16u, voff = koff;
#define DMA_K(t, slot) glds16(kbase + (size_t)(t) * 8192, koff, (unsigned)__builtin_amdgcn_readfirstlane((int)(lds0 + L_K + (slot) * KSLOT + wid * 1024)))
#define DMA_V0(t, slot) glds16(vbase + (size_t)(t) * 16384, voff, (unsigned)__builtin_amdgcn_readfirstlane((int)(lds0 + L_V + (slot) * VSLOT + wid * 1024)))
#define DMA_V1(t, slot) glds16(vbase + (size_t)(t) * 16384 + 8192, voff, (unsigned)__builtin_amdgcn_readfirstlane((int)(lds0 + L_V + (slot) * VSLOT + (wid + 8) * 1024)))
#define DMA_V(t, slot) do { DMA_V0(t, slot); DMA_V1(t, slot); } while (0)
#define KLD(i, kp) kf[i] = *(const LAS bf16x8*)((const LAS unsigned char*)((unsigned)(uintptr_t)(kp) ^ (unsigned)(((i) >> 1) << 5)) + ((i) & 1) * 4096)
#define VRD(i, vp) do { vlo[(i) & 7] = vtr((vp) + ((i) >> 2) * 4096 + ((i) & 3) * 1024); vhi[(i) & 7] = vtr((vp) + ((i) >> 2) * 4096 + ((i) & 3) * 1024 + 512); } while (0)
#define VFR(i) ((bf16x8){vlo[(i) & 7][0], vlo[(i) & 7][1], vlo[(i) & 7][2], vlo[(i) & 7][3], vhi[(i) & 7][0], vhi[(i) & 7][1], vhi[(i) & 7][2], vhi[(i) & 7][3]})
#define EXP2S(i) do { if ((i) < 8) { S0[2 * (i)] = __builtin_amdgcn_exp2f(S0[2 * (i)]); S0[2 * (i) + 1] = __builtin_amdgcn_exp2f(S0[2 * (i) + 1]); \
                          if ((i) > 0) { sacc += S0[2 * (i) - 2]; sacc += S0[2 * (i) - 1]; } asm volatile("" : "+v"(S0), "+v"(sacc)); } \
                      else { S1[2 * (i) - 16] = __builtin_amdgcn_exp2f(S1[2 * (i) - 16]); S1[2 * (i) - 15] = __builtin_amdgcn_exp2f(S1[2 * (i) - 15]); \
                          if ((i) == 8) { sacc += S0[14]; sacc += S0[15]; } else { sacc += S1[2 * (i) - 18]; sacc += S1[2 * (i) - 17]; } asm volatile("" : "+v"(S1), "+v"(sacc)); } } while (0)
#define QK_PLAIN() do { const bf16x8 q0_ = QF(0), q1_ = QF(1), q2_ = QF(2), q3_ = QF(3); S0 = MF(kf[0], q0_, zero16); S1 = MF(kf[1], q0_, zero16); S0 = MF(kf[2], q1_, S0); S1 = MF(kf[3], q1_, S1); \
        S0 = MF(kf[4], q2_, S0); S1 = MF(kf[5], q2_, S1); S0 = MF(kf[6], q3_, S0); S1 = MF(kf[7], q3_, S1); } while (0)
#define MASK(t) do { if (64 * (t) + 63 > wave_qmin) { const int kb_ = 64 * (t) + 4 * hi; \
        _Pragma("unroll") for (int r = 0; r < 16; ++r) { const int kv_ = kb_ + (r & 3) + 8 * (r >> 2); if (kv_ > qrow) S0[r] = -INFINITY; if (kv_ + 32 > qrow) S1[r] = -INFINITY; } } } while (0)
#define ROWMAX(rm) do { asm volatile("s_nop 15\n\ts_nop 7" : "+v"(S0), "+v"(S1)); \
        float a_ = max3f(S0[0], S0[1], S1[0]), b_ = max3f(S0[2], S0[3], S1[1]); a_ = max3f(a_, S1[2], S1[3]); \
        _Pragma("unroll") for (int r = 4; r < 16; r += 4) { a_ = max3f(a_, S0[r], S0[r + 1]); b_ = max3f(b_, S0[r + 2], S0[r + 3]); a_ = max3f(a_, S1[r], S1[r + 1]); b_ = max3f(b_, S1[r + 2], S1[r + 3]); } \
        rm = swap_max(max3f(a_, b_, b_)); } while (0)
#define SUMPACK_FULL() do { float sum_ = 0.f; _Pragma("unroll") for (int r = 0; r < 16; ++r) sum_ += S0[r] + S1[r]; l_run += sum_; PACK(); } while (0)
#define PACK() do { \
        pa[0] = (u32x4){cvtpk(S0[0], S0[1]), cvtpk(S0[2], S0[3]), cvtpk(S0[4], S0[5]), cvtpk(S0[6], S0[7])}; pa[1] = (u32x4){cvtpk(S0[8], S0[9]), cvtpk(S0[10], S0[11]), cvtpk(S0[12], S0[13]), cvtpk(S0[14], S0[15])}; \
        pa[2] = (u32x4){cvtpk(S1[0], S1[1]), cvtpk(S1[2], S1[3]), cvtpk(S1[4], S1[5]), cvtpk(S1[6], S1[7])}; pa[3] = (u32x4){cvtpk(S1[8], S1[9]), cvtpk(S1[10], S1[11]), cvtpk(S1[12], S1[13]), cvtpk(S1[14], S1[15])}; } while (0)
#define PAF(k) __builtin_bit_cast(bf16x8, pa[k])
        DMA_K(0, 0); DMA_V(0, 0); DMA_K(1, 1); DMA_K(2, 2);
        bf16x8 kf[8];
        bf16x8 qr[4];
#pragma unroll
        for (int d0 = 0; d0 < 4; ++d0) qr[d0] = *(const bf16x8*)(qbase + (unsigned)(r32 * D + d0 * 16 + hi * 8) * 2u);
#define QF(d0) qr[d0]
        float m_run = 0.f, l_run = 0.f;
        f32x16 o[4], S0, S1; u32x4 pa[4]; const f32x16 zero16 = {0.f, 0.f, 0.f, 0.f, 0.f, 0.f, 0.f, 0.f, 0.f, 0.f, 0.f, 0.f, 0.f, 0.f, 0.f, 0.f}; s16x4 vlo[8], vhi[8];
#pragma unroll
        for (int d = 0; d < 4; ++d)
#pragma unroll
            for (int r = 0; r < 16; ++r) o[d][r] = 0.f;
        asm volatile("s_waitcnt vmcnt(4)" ::: "memory"); __builtin_amdgcn_s_barrier();
#pragma unroll
        for (int i = 0; i < 8; ++i) KLD(i, kp0);
        QK_PLAIN(); MASK(0);
        f32x16 negm;
        { float rm; ROWMAX(rm); m_run = rm;
#pragma unroll
          for (int r = 0; r < 16; ++r) negm[r] = -rm;
#pragma unroll
          for (int r = 0; r < 16; ++r) { S0[r] = __builtin_amdgcn_exp2f(S0[r] - rm); S1[r] = __builtin_amdgcn_exp2f(S1[r] - rm); } }
        SUMPACK_FULL();
        asm volatile("s_waitcnt vmcnt(0) lgkmcnt(0)" ::: "memory"); __builtin_amdgcn_s_barrier();
        DMA_K(3, 0); DMA_V(1, 1);
#pragma unroll
        for (int i = 0; i < 8; ++i) KLD(i, kp0 + KSLOT);
        asm volatile("s_waitcnt lgkmcnt(0)" ::: "memory"); __builtin_amdgcn_s_barrier();
        int s0 = 0, s1 = 1, s2 = 2;
#define GAPB(i, QKF, LDKF) do { o[(i) >> 2] = MF(PAF((i) & 3), VFR(i), o[(i) >> 2]); if (QKF) EXP2S(i); if ((i) < 8) VRD((i) + 8, vp); else if (LDKF) KLD((i) - 8, kpn); SB(); } while (0)
#define ITER(QKF, PVF, LDKF, MSKF) do { \
            const LAS unsigned char* vp = vp0 + s0 * VSLOT; const LAS unsigned char* kpn = kp0 + s2 * KSLOT; \
            SB(); \
            if (QKF && PVF) { \
                const bf16x8 q0_ = QF(0), q1_ = QF(1), q2_ = QF(2), q3_ = QF(3); SB(); \
                VRD(0, vp); SB(); S0 = MF(kf[0], q0_, negm); SB(); if (t + 3 < NT) DMA_K(t + 3, s1); VRD(1, vp); SB(); S1 = MF(kf[1], q0_, negm); SB(); \
                VRD(2, vp); SB(); S0 = MF(kf[2], q1_, S0); SB(); if (t + 1 < NT) DMA_V0(t + 1, s2); VRD(3, vp); SB(); S1 = MF(kf[3], q1_, S1); SB(); \
                VRD(4, vp); SB(); S0 = MF(kf[4], q2_, S0); SB(); if (t + 1 < NT) DMA_V1(t + 1, s2); VRD(5, vp); SB(); S1 = MF(kf[5], q2_, S1); SB(); \
                VRD(6, vp); SB(); S0 = MF(kf[6], q3_, S0); SB(); VRD(7, vp); SB(); S1 = MF(kf[7], q3_, S1); SB(); \
            } else { if (PVF) { VRD(0, vp); VRD(1, vp); VRD(2, vp); VRD(3, vp); VRD(4, vp); VRD(5, vp); VRD(6, vp); VRD(7, vp); SB(); } \
                if (t + 3 < NT) DMA_K(t + 3, s1); \
                if (t + 1 < NT) DMA_V(t + 1, s2); } \
            float sacc = 0.f; \
            if (QKF && MSKF) MASK(t); \
            SB(); \
            if (PVF) { \
                GAPB(0, QKF, LDKF); GAPB(1, QKF, LDKF); GAPB(2, QKF, LDKF); GAPB(3, QKF, LDKF); GAPB(4, QKF, LDKF); GAPB(5, QKF, LDKF); GAPB(6, QKF, LDKF); GAPB(7, QKF, LDKF); \
                GAPB(8, QKF, LDKF); GAPB(9, QKF, LDKF); GAPB(10, QKF, LDKF); GAPB(11, QKF, LDKF); GAPB(12, QKF, LDKF); GAPB(13, QKF, LDKF); GAPB(14, QKF, LDKF); GAPB(15, QKF, LDKF); \
            } \
            if (QKF) { \
                sacc += S1[14]; sacc += S1[15]; \
                if (__any(sacc > BIGP)) { \
                    const float sm = swap_max(sacc); \
                    const float e_ = (sm > BIGP) ? ceilf(__builtin_amdgcn_logf(sm)) : 0.f; const float fsc = __builtin_amdgcn_exp2f(-e_); \
                    m_run += e_; l_run *= fsc; sacc *= fsc; \
                    _Pragma("unroll") for (int r = 0; r < 16; ++r) negm[r] = -m_run; \
                    _Pragma("unroll") for (int r = 0; r < 16; ++r) { S0[r] *= fsc; S1[r] *= fsc; } \
                    if (hi == 0) wsf[r32] = fsc; \
                    asm volatile("s_waitcnt lgkmcnt(0)" ::: "memory"); \
                    _Pragma("unroll") for (int r = 0; r < 16; ++r) { const float fr = wsf[crow(r, hi)]; \
                        _Pragma("unroll") for (int d = 0; d < 4; ++d) o[d][r] *= fr; } \
                } \
                l_run += sacc; PACK(); \
            } \
        } while (0)
#define CLOSE() do { if (t + 3 < NT) asm volatile("s_waitcnt vmcnt(3) lgkmcnt(0)" ::: "memory"); \
            else if (t + 1 < NT) asm volatile("s_waitcnt vmcnt(2) lgkmcnt(0)" ::: "memory"); \
            else asm volatile("s_waitcnt vmcnt(0) lgkmcnt(0)" ::: "memory"); \
            __builtin_amdgcn_s_barrier(); { const int tmp = s0; s0 = s1; s1 = s2; s2 = tmp; } } while (0)
        int t = 1;
        for (; t < NT - 4; ++t) { ITER(1, 1, 1, 0); CLOSE(); }
        const int t_last = wave_qmax >> 6;
        for (; t <= t_last; ++t) { ITER(1, 1, 1, 1); CLOSE(); }
        { ITER(0, 1, 0, 0); CLOSE(); ++t; }
        for (; t <= NT; ++t) { ITER(0, 0, 0, 0); CLOSE(); }
#undef GAPB
#undef ITER
#undef CLOSE
#undef DMA_K
#undef DMA_V
#undef DMA_V0
#undef DMA_V1
#undef KLD
#undef VRD
#undef VFR
#undef EXP2S
#undef QK_PLAIN
#undef QF
#undef MASK
#undef ROWMAX
#undef SUMPACK_FULL
#undef PACK
#undef PAF
        const float lt = swap_sum(l_run);
        if (hi == 0) wsf[32 + r32] = lt;
        asm volatile("s_waitcnt lgkmcnt(0)" ::: "memory");
#pragma unroll
        for (int r = 0; r < 16; ++r) { const float il = __builtin_amdgcn_rcpf(wsf[32 + crow(r, hi)]);
#pragma unroll
            for (int d = 0; d < 4; ++d) o[d][r] *= il; }
        int lane2 = lane; asm volatile("" : "+v"(lane2));
        float* o0p = T.o0s + ((size_t)(bx * 8 + wid) * 64) * 64 + (unsigned)lane2;
        if (map == 0) {
#pragma unroll
            for (int d = 0; d < 4; ++d)
#pragma unroll
                for (int r = 0; r < 16; ++r) o0p[(d * 16 + r) * 64] = o[d][r];
        } else {
            float sg[4], rs[16];
#pragma unroll
            for (int d = 0; d < 4; ++d) sg[d] = T.subg[32 * d + (lane2 & 31)] * T.oml;
#pragma unroll
            for (int r = 0; r < 16; ++r) {
                float ss = 0.f;
#pragma unroll
                for (int d = 0; d < 4; ++d) { const float v = o0p[(d * 16 + r) * 64] - T.lam * o[d][r]; o[d][r] = v; ss += v * v; }
                ss += __shfl_xor(ss, 1); ss += __shfl_xor(ss, 2); ss += __shfl_xor(ss, 4); ss += __shfl_xor(ss, 8); ss += __shfl_xor(ss, 16);
                rs[r] = __builtin_amdgcn_rsqf(ss * (1.f / 128.f) + SUBLN_EPS);
            }
            LAS bf16_t* stg = (LAS bf16_t*)(lds + L_Q + wid * 4096);
            bf16_t* Ow = T.O + (rowbase + q0 + wid * 32) * D + h * 128;
#pragma unroll
            for (int hp = 0; hp < 2; ++hp) {
#pragma unroll
                for (int r = 0; r < 16; ++r)
#pragma unroll
                    for (int dd = 0; dd < 2; ++dd) stg[crow(r, hi) * 64 + dd * 32 + r32] = (bf16_t)f2bf(o[2 * hp + dd][r] * rs[r] * sg[2 * hp + dd]);
                asm volatile("s_waitcnt lgkmcnt(0)" ::: "memory");
#pragma unroll
                for (int i = 0; i < 4; ++i) { const int row = i * 8 + (lane2 >> 3), ch = lane2 & 7;
                    const u32x4 v = *(const LAS u32x4*)(stg + row * 64 + ch * 8); *(u32x4*)(Ow + (size_t)row * D + hp * 64 + ch * 8) = v; }
                asm volatile("s_waitcnt lgkmcnt(0)" ::: "memory");
            }
        }
        asm volatile("s_waitcnt lgkmcnt(0)" ::: "memory");
        __builtin_amdgcn_s_barrier();
    }
#undef SB
#undef MF
}
__device__ __forceinline__ void attn_phase(LAS unsigned char* lds, const Tensors& T, int G, int vcu, int bx, int tid) {
    asm volatile("" : "+v"(tid));
    const int nun = (G == 256) ? 4 : (BATCH * NH * (SEQ / 256) - vcu + G - 1) / G;
    for (int i = 0; i < nun; ++i) {
        int bh, qb;
        if (G == 256) { const int s = vcu & 7; bh = vcu >> 3; qb = (i == 0) ? s : (i == 1) ? 15 - s : (i == 2) ? 16 + s : 31 - s; }
        else { const int u = vcu + i * G; bh = u >> 5; qb = u & 31; }
        attn_unit(bh >> 3, bh & 7, qb, T, lds, tid, bx);
    }
}
}

#define XB_TMO      128
#define XB_XCNT(j)  (256  + 64 * (j))
#define XB_XSUB(j)  (1280 + 64 * (j))
#define XB_XGEN(j)  (2304 + 64 * (j))
#define XB_TOP      3328
#define XB_TOPGEN   3392
#define XCD_BAR_WORDS 3456
#define XB_SPIN_CAP (1u << 18)
__device__ __forceinline__ unsigned xb_ld(unsigned* p)              { return __hip_atomic_load(p, __ATOMIC_RELAXED, __HIP_MEMORY_SCOPE_AGENT); }
__device__ __forceinline__ unsigned xb_add(unsigned* p, unsigned v) { return __hip_atomic_fetch_add(p, v, __ATOMIC_RELAXED, __HIP_MEMORY_SCOPE_AGENT); }
__device__ __forceinline__ unsigned xb_xcc_id() { return (unsigned)__builtin_amdgcn_s_getreg((3 << 11) | 20) & 0xFu; }
#define XB_SPIN(cond, bar) do { unsigned _sp = 0; while (cond) { __builtin_amdgcn_s_sleep(1); \
    if ((++_sp & 255u) == 0u) { if (xb_ld(&(bar)[XB_TMO])) break; if (_sp > XB_SPIN_CAP) { atomicAdd(&(bar)[XB_TMO], 1u); break; } } } } while (0)
struct XcdBarrier { unsigned* bar; unsigned x; volatile LAS unsigned* st; };
__device__ __forceinline__ XcdBarrier xcd_barrier_post(unsigned* bar, volatile LAS unsigned* st, bool t0  ) {
    XcdBarrier b; b.bar = bar; b.x = xb_xcc_id(); b.st = st;
    if (t0) (void)xb_add(&bar[XB_XCNT(b.x)], 1u);
    return b;
}
__device__ __forceinline__ void xcd_barrier_complete(unsigned* bar, unsigned x, unsigned& nloc, unsigned& nx) {
    const unsigned G = gridDim.x * gridDim.y * gridDim.z;
    unsigned sum, cnt, mine, sp = 0u;
    for (;;) {
        sum = 0u; cnt = 0u; mine = 0u;
#pragma unroll
        for (unsigned j = 0; j < 16; ++j) { const unsigned c = xb_ld(&bar[XB_XCNT(j)]); sum += c; cnt += (c > 0u) ? 1u : 0u; mine = (j == x) ? c : mine; }
        if (sum == G) break;
        __builtin_amdgcn_s_sleep(1);
        if ((++sp & 255u) == 0u) { if (xb_ld(&bar[XB_TMO])) break; if (sp > XB_SPIN_CAP) { atomicAdd(&bar[XB_TMO], 1u); break; } }
    }
    nloc = mine > 0u ? mine : 1u; nx = cnt > 0u ? cnt : 1u;
}
__device__ __forceinline__ void xcd_barrier(const XcdBarrier& b, bool t0  ) {
    asm volatile("s_waitcnt vmcnt(0)" ::: "memory");
    __syncthreads();
    if (t0) {
        unsigned* bar = b.bar;
        __builtin_amdgcn_s_waitcnt(0);
        unsigned nloc = b.st[0], nx = b.st[1];
        if (nloc == 0u) { xcd_barrier_complete(bar, b.x, nloc, nx); b.st[0] = nloc; b.st[1] = nx; }
        const unsigned old = xb_add(&bar[XB_XSUB(b.x)], 1u);
        const unsigned gen = old / nloc;
        if (old + 1u == (gen + 1u) * nloc) {
            __builtin_amdgcn_fence(__ATOMIC_RELEASE, "agent");
            asm volatile("s_waitcnt vmcnt(0)" ::: "memory");
            const unsigned og = xb_add(&bar[XB_TOP], 1u);
            const unsigned tg = og / nx;
            if (og + 1u == (tg + 1u) * nx) xb_add(&bar[XB_TOPGEN], 1u);
            else XB_SPIN(xb_ld(&bar[XB_TOPGEN]) == tg, bar);
            __builtin_amdgcn_fence(__ATOMIC_ACQUIRE, "agent");
            xb_add(&bar[XB_XGEN(b.x)], 1u);
            asm volatile("s_waitcnt vmcnt(0)" ::: "memory");
        } else {
            XB_SPIN(xb_ld(&bar[XB_XGEN(b.x)]) == gen, bar);
            __builtin_amdgcn_fence(__ATOMIC_ACQUIRE, "agent");
            asm volatile("s_waitcnt vmcnt(0)" ::: "memory");
        }
    }
    __syncthreads();
}

constexpr int NWAVES = 8, LDS_BYTES = 147456;
struct Frame {
    LAS unsigned char* lds; unsigned* ctl; int tid, lane, wave, G, gw, NGW, bx, vcu;
    float* out; unsigned char* ws;
};

constexpr int RING_OFF = 0, LDSX_OFF = 131072;
constexpr int LX_MISC = LDSX_OFF;
constexpr int LX_TSTART = LDSX_OFF + 128;
constexpr int LX_CNT = LDSX_OFF + 384;
constexpr int LX_TOKOFF = LDSX_OFF + 1024;
constexpr int LX_DEST = LDSX_OFF + 6144;
constexpr int LX_GW = LDSX_OFF + 11264;
static_assert(LX_GW + 5120 <= LDS_BYTES, "LDS map");

__device__ __forceinline__ void tr64_item(const float* src, int N, int k0, int n0, bf16_t* dst, int ldk, int dstrow0, LAS unsigned* tt, int lane) {
    const int nc = lane & 15, kp = lane >> 4;
    const float* sp = src + (size_t)(k0 + 2 * kp) * N + n0 + 4 * nc;
    f32x4 a[8], b[8];
#pragma unroll
    for (int i = 0; i < 8; ++i) { a[i] = *(const f32x4*)(sp + (size_t)(8 * i) * N); b[i] = *(const f32x4*)(sp + (size_t)(8 * i + 1) * N); }
#pragma unroll
    for (int i = 0; i < 8; ++i)
#pragma unroll
        for (int q = 0; q < 4; ++q) { const int n = 4 * nc + q; tt[n * 32 + ((kp + 4 * i) ^ ((nc & 7) << 2))] = cvt_pk_bf16(a[i][q], b[i][q]); }
    asm volatile("s_waitcnt lgkmcnt(0)" ::: "memory");
    const int c = lane & 7;
#pragma unroll
    for (int j = 0; j < 8; ++j) { const int n = (lane >> 3) + 8 * j;
        const u32x4 o = *(const LAS u32x4*)(tt + n * 32 + ((c ^ ((n >> 2) & 7)) << 2));
        *(u32x4*)(dst + (size_t)(dstrow0 + n) * ldk + k0 + 8 * c) = o; }
    asm volatile("s_waitcnt lgkmcnt(0)" ::: "memory");
}
__device__ __forceinline__ void convert_dense(Frame& F, const Args& A) {
    LAS unsigned* tt = (LAS unsigned*)(F.lds + RING_OFF + F.wave * 8192);
    for (int it = F.gw; it < 3200; it += F.NGW) {
        int r = it;
        if (r < 1536) { const int j = r / 768; r %= 768; tr64_item(A.in[1] + (size_t)j * D * QKVW, QKVW, (r / 48) * 64, (r % 48) * 64, (bf16_t*)(F.ws + WS_WQKV) + (size_t)j * QKVW * D, D, (r % 48) * 64, tt, F.lane); continue; } r -= 1536;
        if (r < 512) { const int j = r / 256; r %= 256; tr64_item(A.in[2] + (size_t)j * D * D, D, (r / 16) * 64, (r % 16) * 64, (bf16_t*)(F.ws + WS_WO) + (size_t)j * D * D, D, (r % 16) * 64, tt, F.lane); continue; } r -= 512;
        if (r < 512) { const int j = r / 256; r %= 256; tr64_item(A.in[8] + (size_t)j * D * D, D, (r / 16) * 64, (r % 16) * 64, (bf16_t*)(F.ws + WS_WIN) + (size_t)j * D * D, D, (r % 16) * 64, tt, F.lane); continue; } r -= 512;
        if (r < 512) { const int j = r / 256; r %= 256; tr64_item(A.in[11] + (size_t)j * D * D, D, (r / 16) * 64, (r % 16) * 64, (bf16_t*)(F.ws + WS_WOUT) + (size_t)j * D * D, D, (r % 16) * 64, tt, F.lane); continue; } r -= 512;
        { const int jg = r / 16; r %= 16;
          tr64_item(A.in[9] + (size_t)jg * 65536, 256, (r / 4) * 64, (r % 4) * 64, (bf16_t*)(F.ws + WS_WGRP) + (size_t)jg * 65536, 256, (r % 4) * 64, tt, F.lane); }
    }
    bf16_t* WRH = (bf16_t*)(F.ws + WS_RTW); bf16_t* WRL = WRH + DEPTH * 48 * D;
    for (int i = F.bx * 512 + F.tid; i < DEPTH * 48 * D; i += F.G * 512) {
        const int k = i & (D - 1), jc = (i >> 10) % 48, l = (i >> 10) / 48;
        const float w = jc < NG ? A.in[14][((size_t)l * D + k) * NG + jc] : (jc < NG + NE ? A.in[16][((size_t)l * D + k) * NE + jc - NG] : 0.f);
        const unsigned h = f2bf(w); WRH[i] = (bf16_t)h; WRL[i] = (bf16_t)f2bf(w - __uint_as_float(h << 16));
    }
}
__device__ __forceinline__ void convert_moe(Frame& F, const Args& A, int layer, int it0, int stride, int it_end = 12288) {
    LAS unsigned* tt = (LAS unsigned*)(F.lds + RING_OFF + F.wave * 8192);
    bf16_t* WGU = (bf16_t*)(F.ws + ((layer & 1) ? WS_WGU2 : WS_WGU)); bf16_t* WD = (bf16_t*)(F.ws + ((layer & 1) ? WS_WD2 : WS_WD));
    for (int it = it0; it < it_end; it += stride) {
        int r = it;
        if (r < 8192) { const int up = r >= 4096; r &= 4095; const int e = r >> 7; r &= 127; const int n0 = (r & 7) * 64;
            tr64_item((up ? A.in[19] : A.in[18]) + ((size_t)layer * NE + e) * D * DE, DE, (r >> 3) * 64, n0, WGU + (size_t)e * 1024 * D, D, (n0 >> 7) * 256 + (n0 & 127) + up * 128, tt, F.lane); continue; }
        r -= 8192; { const int e = r >> 7; r &= 127;
            tr64_item(A.in[20] + ((size_t)layer * NE + e) * DE * D, D, (r >> 4) * 64, (r & 15) * 64, WD + (size_t)e * D * DE, DE, (r & 15) * 64, tt, F.lane); }
    }
}
__device__ __forceinline__ pg8::MoeOrder moe_prepare(Frame& F, int layer, int vcu, bool build) {
    LAS int* tstart = (LAS int*)(F.lds + LX_TSTART); LAS int* cntl = (LAS int*)(F.lds + LX_CNT); LAS int* misc = (LAS int*)(F.lds + LX_MISC);
    LAS unsigned* tokoff = (LAS unsigned*)(F.lds + LX_TOKOFF); LAS int* destl = (LAS int*)(F.lds + LX_DEST); LAS float* gwl = (LAS float*)(F.lds + LX_GW);
    const unsigned* cnt = F.ctl + CW_CNT + layer * NE * 16; const int* LTOK = (const int*)(F.ws + WS_LTOK); const float* GATEW = (const float*)(F.ws + WS_GATEW);
    if (build) {
        if (F.wave == 0) {
            const int c = F.lane < NE ? (int)cnt[F.lane * 16] : 0; int inc = (c + 255) >> 8;
#pragma unroll
            for (int o = 1; o < 32; o <<= 1) { const int v = __shfl_up(inc, o); if ((F.lane & 31) >= o) inc += v; }
            if (F.lane < NE) { tstart[F.lane] = inc - ((c + 255) >> 8); cntl[F.lane] = c; if (F.lane == NE - 1) { tstart[NE] = inc; misc[16] = inc; } }
        }
        __syncthreads();
    }
    pg8::MoeOrder S; S.tstart = tstart; S.cntl = cntl; S.tokoff = tokoff; S.ue = misc + 20; S.ntiles = misc[16]; S.G = F.G; S.c = vcu; S.ilo = 0; S.ihi = 1 << 20;
    if (build) {
        for (int k = F.tid; k < 5 * 256; k += NWAVES * 64) { const int i = k >> 8, r = k & 255; pg8::Unit u;
            if (S.find(i, u)) { if (r == 0) misc[20 + i] = u.e; const int p = u.pos0 + r; const int dest = p < u.cnt ? LTOK[(size_t)u.e * LIST_CAP + p] : -1;
                tokoff[k] = dest < 0 ? 0u : (unsigned)(dest >> 1) * (unsigned)(D * 2); destl[k] = dest; gwl[k] = dest < 0 ? 0.f : GATEW[dest]; } }
        __syncthreads();
    }
    return S;
}

__device__ __forceinline__ void phase_prologue(Frame& F, const Args& A) {
    const float* x = A.in[0]; bf16_t* HB = (bf16_t*)(F.ws + WS_HB);
    const size_t n8 = (size_t)NTOK * D / 8;
    typedef __attribute__((address_space(1))) const f32x4 gcf4_t; typedef __attribute__((address_space(1))) u32x4 gu4_t;
    const size_t xstride = (size_t)F.G * 512;
    for (size_t i0 = (size_t)F.bx * 512 + F.tid; i0 < n8; i0 += xstride * 8) {
        f32x4 a[8], b[8];
#pragma unroll
        for (int u = 0; u < 8; ++u) { const size_t i = i0 + u * xstride; if (i < n8) { a[u] = *(gcf4_t*)(x + i * 8); b[u] = *(gcf4_t*)(x + i * 8 + 4); } }
#pragma unroll
        for (int u = 0; u < 8; ++u) { const size_t i = i0 + u * xstride;
            if (i < n8) { u32x4 o; o.x = pk2(a[u].x, a[u].y); o.y = pk2(a[u].z, a[u].w); o.z = pk2(b[u].x, b[u].y); o.w = pk2(b[u].z, b[u].w); *(gu4_t*)(HB + i * 8) = o; } }
    }
    float* rc = (float*)(F.ws + WS_ROPE); float* rs = rc + SEQ * 8;
    for (int i = F.bx * 512 + F.tid; i < SEQ * 8; i += F.G * 512) {
        const int pos = i >> 3, fi = i & 7;
        const float inv = (float)exp2(-(double)fi * (1.0 / 8.0) * 18.931568569324174);
        const float ang = (float)pos * inv;
        const double rev = (double)ang * 0.15915494309189535; const float fr = (float)(rev - floor(rev));
        rc[i] = __builtin_amdgcn_cosf(fr); rs[i] = __builtin_amdgcn_sinf(fr);
    }
    if (F.bx == 0 && F.tid < 2) {
        const int j = F.tid; float s1 = 0.f, s2 = 0.f;
        for (int i = 0; i < HD; ++i) { s1 += A.in[3][j * HD + i] * A.in[4][j * HD + i]; s2 += A.in[5][j * HD + i] * A.in[6][j * HD + i]; }
        const float li = j == 0 ? 0.2f : 0.47071301834358416f;
        ((float*)F.ctl)[CW_LAM + j] = expf(s1) - expf(s2) + li;
    }
}

__device__ __forceinline__ void unpack8(const u32x4 v, float (&f)[8]) {
    f[0] = __uint_as_float(v.x << 16); f[1] = __uint_as_float(v.x & 0xffff0000u); f[2] = __uint_as_float(v.y << 16); f[3] = __uint_as_float(v.y & 0xffff0000u);
    f[4] = __uint_as_float(v.z << 16); f[5] = __uint_as_float(v.z & 0xffff0000u); f[6] = __uint_as_float(v.w << 16); f[7] = __uint_as_float(v.w & 0xffff0000u);
}
template <int W> __device__ __forceinline__ void pool_block(const bf16_t* U, bf16_t* PB, int row0, int col) {
    const int pos0 = row0 & (SEQ - 1);
    u32x4 v[16 + W - 1];
#pragma unroll
    for (int i = 0; i < 16 + W - 1; ++i) { const int back = W - 1 - i; const int r = (back > 0 && pos0 - back < 0) ? row0 : row0 - back; v[i] = *(const u32x4*)(U + (size_t)r * D + col); }
    float s[8];
#pragma unroll
    for (int j = 0; j < 8; ++j) s[j] = 0.f;
#pragma unroll
    for (int t = 0; t < W; ++t) { float f[8]; unpack8(v[W - 1 - t], f); const float m = (t <= pos0) ? 1.f : 0.f;
#pragma unroll
        for (int j = 0; j < 8; ++j) s[j] += m * f[j]; }
#pragma unroll
    for (int o = 0; o < 16; ++o) {
        float c[8]; unpack8(v[W - 1 + o], c);
        if (o > 0) { float lv[8]; unpack8(v[o - 1], lv); const float m = (pos0 + o - W >= 0) ? 1.f : 0.f;
#pragma unroll
            for (int j = 0; j < 8; ++j) s[j] += c[j] - m * lv[j]; }
        const int pos = pos0 + o; const float inv = 1.f / (float)((pos + 1 < W) ? pos + 1 : W);
        u32x4 ov; ov.x = cvt_pk_bf16(s[0] * inv - c[0], s[1] * inv - c[1]); ov.y = cvt_pk_bf16(s[2] * inv - c[2], s[3] * inv - c[3]);
        ov.z = cvt_pk_bf16(s[4] * inv - c[4], s[5] * inv - c[5]); ov.w = cvt_pk_bf16(s[6] * inv - c[6], s[7] * inv - c[7]);
        *(u32x4*)(PB + (size_t)(row0 + o) * D + col) = ov;
    }
}
__device__ __forceinline__ void phase_pool(Frame& F) {
    const bf16_t* U = (const bf16_t*)(F.ws + WS_Q); bf16_t* PB = (bf16_t*)(F.ws + WS_K);
    for (int it = F.gw; it < 4 * (NTOK / 32); it += F.NGW) {
        const int g = it & 3, rb = (it >> 2) * 2 + (F.lane >> 5), row0 = rb * 16, col = g * 256 + (F.lane & 31) * 8;
        if (g == 0) pool_block<2>(U, PB, row0, col); else if (g == 1) pool_block<4>(U, PB, row0, col); else if (g == 2) pool_block<8>(U, PB, row0, col); else pool_block<16>(U, PB, row0, col);
    }
}

__device__ __forceinline__ void ln_row(f32x4 (&v)[4], const f32x4 (&gg)[4], const f32x4 (&bb)[4]) {
    float s = 0.f;
#pragma unroll
    for (int j = 0; j < 4; ++j) s += (v[j].x + v[j].y) + (v[j].z + v[j].w);
    const float mean = wave_sum(s) * (1.f / D); float s2 = 0.f;
#pragma unroll
    for (int j = 0; j < 4; ++j) { v[j] = v[j] - mean; s2 += (v[j].x * v[j].x + v[j].y * v[j].y) + (v[j].z * v[j].z + v[j].w * v[j].w); }
    const float rstd = 1.0f / sqrtf(wave_sum(s2) * (1.f / D) + LN_EPS);
#pragma unroll
    for (int j = 0; j < 4; ++j) v[j] = v[j] * rstd * gg[j] + bb[j];
}

__device__ __forceinline__ void phase_route(Frame& F, const Args& A, int layer) {
    typedef short bf16x8 __attribute__((ext_vector_type(8)));
    const bf16_t* T = (const bf16_t*)(F.ws + WS_T); bf16_t* HB = (bf16_t*)(F.ws + WS_HB);
    const float* g = A.in[12] + (size_t)(layer * 2) * D; const float* b = A.in[13] + (size_t)(layer * 2) * D;
    const float* bg = A.in[15] + layer * NG; const float* be = A.in[17] + layer * NE;
    const bf16_t* WRH = (const bf16_t*)(F.ws + WS_RTW) + (size_t)layer * 48 * D; const bf16_t* WRL = WRH + DEPTH * 48 * D;
    unsigned* cnt = F.ctl + CW_CNT + layer * NE * 16; int* LTOK = (int*)(F.ws + WS_LTOK); float* GATEW = (float*)(F.ws + WS_GATEW);
    constexpr int RW_PITCH = 1040, RW_HL = 36 * RW_PITCH, LG_OFF = 81920, GB_OFF = 114688;
    LAS unsigned char* rw = F.lds + RING_OFF;
    LAS float* gl = (LAS float*)(F.lds + RING_OFF + GB_OFF); LAS float* bl_ = gl + D;
    LAS unsigned* lcnt = (LAS unsigned*)(F.lds + RING_OFF + GB_OFF + 8192); LAS unsigned* lbase = lcnt + NE;
    if (F.tid < NE) lcnt[F.tid] = 0u;
    for (int i = F.tid; i < D / 4; i += NWAVES * 64) { *(LAS f32x4*)(gl + 4 * i) = *(const f32x4*)(g + 4 * i); *(LAS f32x4*)(bl_ + 4 * i) = *(const f32x4*)(b + 4 * i); }
    LAS float* lg = (LAS float*)(F.lds + RING_OFF + LG_OFF + F.wave * 4096);
    const int r16 = F.lane & 15, kq = F.lane >> 4;
    for (int g0 = F.bx * NWAVES; g0 < NTOK / 16; g0 += F.G * NWAVES) {
        const int grp = g0 + F.wave, row = grp * 16 + r16;
        const bf16_t* trow = T + (size_t)row * D + 8 * kq; bf16_t* hbrow = HB + (size_t)row * D + 8 * kq;
        float sum = 0.f, ss = 0.f;
        { const float* st = (const float*)(F.ws + WS_STATS) + ((size_t)row * 16 + 4 * kq) * 2;
          const f32x4 p0 = *(const f32x4*)st, p1 = *(const f32x4*)(st + 4); sum = (p0.x + p0.z) + (p1.x + p1.z); ss = (p0.y + p0.w) + (p1.y + p1.w); }
        sum += __shfl_xor(sum, 16); sum += __shfl_xor(sum, 32); ss += __shfl_xor(ss, 16); ss += __shfl_xor(ss, 32);
        const float mean = sum * (1.f / D), var = fmaxf(ss * (1.f / D) - mean * mean, 0.f), rstd = 1.0f / sqrtf(var + LN_EPS);
        f32x4 acc[3];
#pragma unroll
        for (int q = 0; q < 3; ++q) acc[q] = (f32x4){0.f, 0.f, 0.f, 0.f};
        int co[3];
#pragma unroll
        for (int q = 0; q < 3; ++q) { const int c = 16 * q + r16; co[q] = (c < 36 ? c : 35) * RW_PITCH + kq * 16; }
        for (int half = 0; half < 2; ++half) {
            __syncthreads();
            for (int p = F.tid; p < 2 * 36 * 64; p += NWAVES * 64) { const int hl = p / 2304, rem = p - hl * 2304, c = rem >> 6, c16 = rem & 63;
                const u32x4 w = *(const u32x4*)((hl ? WRL : WRH) + (size_t)c * D + half * 512 + c16 * 8);
                *(LAS u32x4*)(rw + hl * RW_HL + c * RW_PITCH + c16 * 16) = w; }
            __syncthreads();
#pragma unroll 4
            for (int s2 = 0; s2 < 16; ++s2) { const int s = half * 16 + s2;
                const u32x4 tw = *(const u32x4*)(trow + 32 * s);
                const f32x4 x0 = (f32x4){__uint_as_float(tw.x << 16), __uint_as_float(tw.x & 0xffff0000u), __uint_as_float(tw.y << 16), __uint_as_float(tw.y & 0xffff0000u)};
                const f32x4 x1 = (f32x4){__uint_as_float(tw.z << 16), __uint_as_float(tw.z & 0xffff0000u), __uint_as_float(tw.w << 16), __uint_as_float(tw.w & 0xffff0000u)};
                const f32x4 g0 = *(const LAS f32x4*)(gl + 32 * s + 8 * kq), g1 = *(const LAS f32x4*)(gl + 32 * s + 8 * kq + 4), b0 = *(const LAS f32x4*)(bl_ + 32 * s + 8 * kq), b1 = *(const LAS f32x4*)(bl_ + 32 * s + 8 * kq + 4);
                const f32x4 y0 = (x0 - mean) * rstd * g0 + b0, y1 = (x1 - mean) * rstd * g1 + b1;
                u32x4 hw; hw.x = cvt_pk_bf16(y0.x, y0.y); hw.y = cvt_pk_bf16(y0.z, y0.w); hw.z = cvt_pk_bf16(y1.x, y1.y); hw.w = cvt_pk_bf16(y1.z, y1.w);
                *(u32x4*)(hbrow + 32 * s) = hw;
                u32x4 lw;
                lw.x = cvt_pk_bf16(y0.x - __uint_as_float(hw.x << 16), y0.y - __uint_as_float(hw.x & 0xffff0000u)); lw.y = cvt_pk_bf16(y0.z - __uint_as_float(hw.y << 16), y0.w - __uint_as_float(hw.y & 0xffff0000u));
                lw.z = cvt_pk_bf16(y1.x - __uint_as_float(hw.z << 16), y1.y - __uint_as_float(hw.z & 0xffff0000u)); lw.w = cvt_pk_bf16(y1.z - __uint_as_float(hw.w << 16), y1.w - __uint_as_float(hw.w & 0xffff0000u));
                const bf16x8 ah = __builtin_bit_cast(bf16x8, hw), al = __builtin_bit_cast(bf16x8, lw);
#pragma unroll
                for (int q = 0; q < 3; ++q) {
                    const bf16x8 bh = *(const LAS bf16x8*)(rw + co[q] + s2 * 64), bl = *(const LAS bf16x8*)(rw + RW_HL + co[q] + s2 * 64);
                    acc[q] = __builtin_amdgcn_mfma_f32_16x16x32_bf16(ah, bh, acc[q], 0, 0, 0);
                    acc[q] = __builtin_amdgcn_mfma_f32_16x16x32_bf16(ah, bl, acc[q], 0, 0, 0);
                    acc[q] = __builtin_amdgcn_mfma_f32_16x16x32_bf16(al, bh, acc[q], 0, 0, 0);
                }
            }
        }
#pragma unroll
        for (int q = 0; q < 3; ++q)
#pragma unroll
            for (int r = 0; r < 4; ++r) lg[(4 * kq + r) * 48 + 16 * q + r16] = acc[q][r];
        asm volatile("s_waitcnt lgkmcnt(0)" ::: "memory");
        int ea = 0, eb = 0; unsigned pa = 0u, pb = 0u;
        if (F.lane < 16) {
            const LAS float* L = lg + F.lane * 48; const int tok = grp * 16 + F.lane;
            float l4[4];
#pragma unroll
            for (int i = 0; i < 4; ++i) l4[i] = L[i] + bg[i];
            int gi = 0; float gm = l4[0];
#pragma unroll
            for (int i = 1; i < 4; ++i) if (l4[i] > gm) { gm = l4[i]; gi = i; }
            float gs = 0.f;
#pragma unroll
            for (int i = 0; i < 4; ++i) gs += expf(l4[i] - gm);
            const float gp = 1.f / gs;
            float ein[8];
#pragma unroll
            for (int j = 0; j < 8; ++j) ein[j] = L[NG + gi * EPG + j] + be[gi * EPG + j];
            int i0 = 0; float v0 = ein[0];
#pragma unroll
            for (int j = 1; j < 8; ++j) if (ein[j] > v0) { v0 = ein[j]; i0 = j; }
            int i1 = -1; float v1 = -INFINITY;
#pragma unroll
            for (int j = 0; j < 8; ++j) if (j != i0 && ein[j] > v1) { v1 = ein[j]; i1 = j; }
            const float e1 = expf(v1 - v0), s0 = 1.f / (1.f + e1), s1 = e1 / (1.f + e1);
            ea = gi * EPG + i0; eb = gi * EPG + i1;
            pa = __hip_atomic_fetch_add(lcnt + ea, 1u, __ATOMIC_RELAXED, __HIP_MEMORY_SCOPE_WORKGROUP); pb = __hip_atomic_fetch_add(lcnt + eb, 1u, __ATOMIC_RELAXED, __HIP_MEMORY_SCOPE_WORKGROUP);
            *(float2*)(GATEW + tok * 2) = make_float2(gp * s0, gp * s1);
        }
        __syncthreads();
        if (F.tid < NE) { const unsigned n = lcnt[F.tid]; lbase[F.tid] = n ? atomicAdd(cnt + F.tid * 16, n) : 0u; }
        __syncthreads();
        if (F.lane < 16) { const int tok = grp * 16 + F.lane;
            LTOK[(size_t)ea * LIST_CAP + lbase[ea] + pa] = tok * 2; LTOK[(size_t)eb * LIST_CAP + lbase[eb] + pb] = tok * 2 + 1; }
        __syncthreads();
        if (F.tid < NE) lcnt[F.tid] = 0u;
    }
    __syncthreads();
}

__device__ __forceinline__ void bf8_to_f(const u32x4 w, f32x4& a, f32x4& b) {
    a = (f32x4){__uint_as_float(w.x << 16), __uint_as_float(w.x & 0xffff0000u), __uint_as_float(w.y << 16), __uint_as_float(w.y & 0xffff0000u)};
    b = (f32x4){__uint_as_float(w.z << 16), __uint_as_float(w.z & 0xffff0000u), __uint_as_float(w.w << 16), __uint_as_float(w.w & 0xffff0000u)};
}
__device__ __forceinline__ void phase_ln2(Frame& F, const Args& A, int layer) {
    bf16_t* HB = (bf16_t*)(F.ws + WS_HB); const bf16_t* Y = (const bf16_t*)(F.ws + WS_Y);
    const float* g = A.in[12] + (size_t)(layer * 2 + 1) * D; const float* b = A.in[13] + (size_t)(layer * 2 + 1) * D;
    const bool last = layer == DEPTH - 1;
    f32x4 gg[4], bb[4];
#pragma unroll
    for (int j = 0; j < 2; ++j) { const int c = 512 * j + 8 * F.lane; gg[2 * j] = *(const f32x4*)(g + c); gg[2 * j + 1] = *(const f32x4*)(g + c + 4); bb[2 * j] = *(const f32x4*)(b + c); bb[2 * j + 1] = *(const f32x4*)(b + c + 4); }
    for (int row = F.gw; row < NTOK; row += F.NGW) {
        f32x4 v[4];
#pragma unroll
        for (int j = 0; j < 2; ++j) { const int c = 512 * j + 8 * F.lane;
            const u32x4 hw = *(const u32x4*)(HB + (size_t)row * D + c), y0 = *(const u32x4*)(Y + (size_t)(2 * row) * D + c), y1 = *(const u32x4*)(Y + (size_t)(2 * row + 1) * D + c);
            f32x4 h0, h1, a0, a1, c0, c1; bf8_to_f(hw, h0, h1); bf8_to_f(y0, a0, a1); bf8_to_f(y1, c0, c1);
            v[2 * j] = h0 * ALPHA + (a0 + c0); v[2 * j + 1] = h1 * ALPHA + (a1 + c1); }
        ln_row(v, gg, bb);
        if (last) {
#pragma unroll
            for (int j = 0; j < 2; ++j) { float* o = F.out + (size_t)row * D + 512 * j + 8 * F.lane; *(f32x4*)o = v[2 * j]; *(f32x4*)(o + 4) = v[2 * j + 1]; }
        } else {
#pragma unroll
            for (int j = 0; j < 2; ++j) { u32x4 o; o.x = cvt_pk_bf16(v[2 * j].x, v[2 * j].y); o.y = cvt_pk_bf16(v[2 * j].z, v[2 * j].w); o.z = cvt_pk_bf16(v[2 * j + 1].x, v[2 * j + 1].y); o.w = cvt_pk_bf16(v[2 * j + 1].z, v[2 * j + 1].w);
                *(u32x4*)(HB + (size_t)row * D + 512 * j + 8 * F.lane) = o; }
        }
    }
}

__device__ __forceinline__ int lane_id_fresh() { int l; asm volatile("v_mbcnt_lo_u32_b32 %0, -1, 0\n\tv_mbcnt_hi_u32_b32 %0, -1, %0" : "=v"(l)); return l; }
__device__ __forceinline__ Frame make_frame(const Args& args, unsigned char* lds, int wave0) {
    Frame F; int wv = wave0; asm volatile("" : "+s"(wv));
    const int ln = lane_id_fresh();
    const int tid = wv * 64 + ln;
    unsigned char* ws = args.ws; asm volatile("" : "+s"(ws));
    F.lds = (LAS unsigned char*)lds; F.tid = tid; F.lane = ln; F.wave = wv;
    int bx = blockIdx.x, G = gridDim.x; asm volatile("" : "+s"(bx), "+s"(G));
    F.bx = bx; F.G = G; F.gw = bx * NWAVES + F.wave; F.NGW = G * NWAVES;
    F.vcu = (G % 8 == 0) ? (bx % 8) * (G / 8) + bx / 8 : bx;
    F.ws = ws; F.out = args.out; F.ctl = (unsigned*)(ws + WS_CTL);
    return F;
}
__device__ __forceinline__ bool in_range(int lo, int hi, int k) { asm volatile("" : "+s"(lo), "+s"(hi), "+s"(k)); return lo <= k && k < hi; }
__global__ void __launch_bounds__(NWAVES * 64, 2) mk_fwd(Args args) {
    extern __shared__ __attribute__((aligned(16))) unsigned char lds[];
    const int wave0 = __builtin_amdgcn_readfirstlane((int)threadIdx.x >> 6);
    for (int u = threadIdx.x; u < (LDS_BYTES - LDSX_OFF) / 4; u += NWAVES * 64) ((LAS unsigned*)((LAS unsigned char*)lds + LDSX_OFF))[u] = 0u;
    __syncthreads();
    const int lo = args.ph_lo, hi = args.ph_hi;
    unsigned* const barw = (unsigned*)(args.ws + WS_CTL) + CW_BAR;
    XcdBarrier bar; bar.bar = barw; bar.x = 0; bar.st = nullptr;
    if (hi - lo > 1) bar = xcd_barrier_post(barw, (volatile LAS unsigned*)((LAS unsigned char*)lds + LX_MISC) + 8, threadIdx.x == 0);
#define IN(k) in_range(lo, hi, (k))
#define SEAM(k) do { if ((k) + 1 < hi) { XcdBarrier bb_ = bar; asm volatile("" : "+s"(bb_.bar));     \
        xcd_barrier(bb_, wave0 == 0 && lane_id_fresh() == 0); } } while (0)
    if (IN(0)) { Frame F = make_frame(args, lds, wave0); phase_prologue(F, args); convert_dense(F, args); SEAM(0); }
    for (int l = 0; l < DEPTH; ++l) {
        const int base = 1 + 8 * l, j = l >> 1; const bool attn = !(l & 1);
        if (IN(base)) {
            Frame F = make_frame(args, lds, wave0); const bf16_t* HB = (const bf16_t*)(F.ws + WS_HB); bf16_t* QB = (bf16_t*)(F.ws + WS_Q);
            if (attn) {
                pg8::Gemm g{HB, (const bf16_t*)(F.ws + WS_WQKV) + (size_t)j * QKVW * D, D, D, D, 0}; pg8::StaticOrder S; S.init(NTOK, QKVW, F.G, F.bx);
                pg8::EpiQKV E{QB, (const float*)(F.ws + WS_ROPE), (const float*)(F.ws + WS_ROPE) + SEQ * 8};
                pg8::gemm_phase<pg8::EpiQKV, pg8::StaticOrder, true, false>(F.lds + RING_OFF, g, S, E, F.tid);
            } else {
                pg8::Gemm g{HB, (const bf16_t*)(F.ws + WS_WIN) + (size_t)j * D * D, D, D, D, 0}; pg8::StaticOrder S; S.init(NTOK, D, F.G, F.bx);
                pg8::EpiBf16S E{QB, nullptr};
                pg8::gemm_phase<pg8::EpiBf16S, pg8::StaticOrder, true, false>(F.lds + RING_OFF, g, S, E, F.tid);
            }
            SEAM(base);
        }
        if (IN(base + 1)) {
            if (attn) {
                Frame F = make_frame(args, lds, wave0);
                att::Tensors T{(const bf16_t*)(F.ws + WS_Q), (const bf16_t*)(F.ws + WS_K), (const bf16_t*)(F.ws + WS_V), (bf16_t*)(F.ws + WS_O), (float*)(F.ws + WS_O0S), args.in[7] + j * VD,
                               ((const float*)F.ctl)[CW_LAM + j], 1.0f - (j == 0 ? 0.2f : 0.47071301834358416f)};
                att::attn_phase(F.lds + RING_OFF, T, F.G, F.vcu, F.bx, F.tid);
            } else { Frame F = make_frame(args, lds, wave0); phase_pool(F); }
            SEAM(base + 1);
        }
        if (IN(base + 2)) {
            if (!attn) {
                Frame F = make_frame(args, lds, wave0);
                pg8::Gemm g{(const bf16_t*)(F.ws + WS_K), (const bf16_t*)(F.ws + WS_WGRP) + (size_t)j * 4 * 65536, D, 256, 256, 256}; pg8::StaticOrder S; S.init(NTOK, D, F.G, F.bx);
                pg8::EpiBf16S E{(bf16_t*)(F.ws + WS_V), args.in[10] + j * D};
                pg8::gemm_phase<pg8::EpiBf16S, pg8::StaticOrder, true, false>(F.lds + RING_OFF, g, S, E, F.tid);
                SEAM(base + 2);
            }
        }
        if (IN(base + 3)) {
            Frame F = make_frame(args, lds, wave0);
            const size_t aoffb = attn ? WS_O : WS_V, woffb = (attn ? WS_WO : WS_WOUT) + (size_t)j * D * D * 2;
            pg8::Gemm g{(const bf16_t*)(F.ws + aoffb), (const bf16_t*)(F.ws + woffb), D, D, D, 0}; pg8::StaticOrder S; S.init(NTOK, D, F.G, F.bx);
            pg8::EpiResid E{l == 0 ? args.in[0] : nullptr, (const bf16_t*)(F.ws + WS_HB), (bf16_t*)(F.ws + WS_T), (float*)(F.ws + WS_STATS)};
            pg8::gemm_phase<pg8::EpiResid, pg8::StaticOrder, true, false>(F.lds + RING_OFF, g, S, E, F.tid);
            SEAM(base + 3);
        }
        if (IN(base + 4)) { Frame F = make_frame(args, lds, wave0); phase_route(F, args, l); if (l == 0) convert_moe(F, args, 0, F.gw, F.NGW);     SEAM(base + 4); }
        if (IN(base + 5)) {
            int nparts = 2; asm volatile("" : "+s"(nparts));
            for (int part = 0; part < nparts; ++part) {
                Frame F = make_frame(args, lds, wave0);
                pg8::MoeOrder S = moe_prepare(F, l, F.vcu, part == 0);
                const int total = S.ntiles * 4, rem = total % F.G, nmax = (total + F.G - 1) / F.G, nidle = rem ? F.G - rem : F.G, rank = rem ? F.vcu - rem : F.vcu;
                const bool conv = (l + 1 < DEPTH) && rank >= 0; const int kpos = conv ? rank % nmax : (1 << 20);
                S.ilo = part ? kpos : 0; S.ihi = part ? (1 << 20) : kpos;
                pg8::Gemm g{(const bf16_t*)(F.ws + WS_HB), (const bf16_t*)(F.ws + ((l & 1) ? WS_WGU2 : WS_WGU)), D, D, D, 0};
                pg8::EpiSwiGLU E{(bf16_t*)(F.ws + WS_ACT)};
                pg8::gemm_phase<pg8::EpiSwiGLU, pg8::MoeOrder, true, true>(F.lds + RING_OFF, g, S, E, F.tid);
                if (part == 0 && conv) { convert_moe(F, args, l + 1, rank * NWAVES + F.wave, nidle * NWAVES, 8192); __syncthreads(); }
            }
            SEAM(base + 5);
        }
        if (IN(base + 6)) {
            int nparts = 2; asm volatile("" : "+s"(nparts));
            for (int part = 0; part < nparts; ++part) {
                Frame F = make_frame(args, lds, wave0);
                pg8::MoeOrder S = moe_prepare(F, l, F.vcu, false);
                const int total = S.ntiles * 4, rem = total % F.G, nmax = (total + F.G - 1) / F.G, nidle = rem ? F.G - rem : F.G, rank = rem ? F.vcu - rem : F.vcu;
                const bool conv = (l + 1 < DEPTH) && rank >= 0; const int kpos = conv ? rank % nmax : (1 << 20);
                S.ilo = part ? kpos : 0; S.ihi = part ? (1 << 20) : kpos;
                pg8::Gemm g{(const bf16_t*)(F.ws + WS_ACT), (const bf16_t*)(F.ws + ((l & 1) ? WS_WD2 : WS_WD)), DE, DE, DE, 0};
                pg8::EpiScatter E{(bf16_t*)(F.ws + WS_Y), (const LAS int*)(F.lds + LX_DEST), (const LAS float*)(F.lds + LX_GW)};
                pg8::gemm_phase<pg8::EpiScatter, pg8::MoeOrder, true, false>(F.lds + RING_OFF, g, S, E, F.tid);
                if (part == 0 && conv) { convert_moe(F, args, l + 1, 8192 + rank * NWAVES + F.wave, nidle * NWAVES, 12288); __syncthreads(); }
            }
            SEAM(base + 6);
        }
        if (IN(base + 7)) { Frame F = make_frame(args, lds, wave0); phase_ln2(F, args, l); SEAM(base + 7); }
    }
#undef IN
#undef SEAM
}

extern "C" void kernel_launch(void* const* d_in, const int* in_sizes, int n_in, void* d_out, int out_size, void* d_ws, size_t ws_size, hipStream_t stream) {
    static int grid = 0;
    if (grid == 0) {
        if (n_in != 21 || out_size != NTOK * D || ws_size < WS_END) { fprintf(stderr, "kernel_launch: unexpected shapes (n_in %d out %d ws %zu); nothing launched\n", n_in, out_size, ws_size); grid = -1; return; }
        int dev = 0, cus = 0;
        if (hipGetDevice(&dev) != hipSuccess || hipDeviceGetAttribute(&cus, hipDeviceAttributeMultiprocessorCount, dev) != hipSuccess) { grid = -1; return; }
        if (hipFuncSetAttribute((const void*)mk_fwd, hipFuncAttributeMaxDynamicSharedMemorySize, LDS_BYTES) != hipSuccess) { grid = -1; return; }
        grid = cus > 0 ? cus : 256;
    }
    if (grid < 0) return;
    unsigned char* ws = (unsigned char*)d_ws;
    if (hipMemsetAsync(ws + WS_CTL, 0, CTL_ZERO_BYTES, stream) != hipSuccess) return;
    Args a{};
    for (int i = 0; i < 21; ++i) a.in[i] = (const float*)d_in[i];
    a.out = (float*)d_out; a.ws = ws; a.ph_lo = 0; a.ph_hi = 1 + 8 * DEPTH;
    hipLaunchKernelGGL(mk_fwd, dim3(grid), dim3(NWAVES * 64), LDS_BYTES, stream, a);
}
```

```cpp
#include <hip/hip_runtime.h>
#include <cstdio>
#include <cstdint>

constexpr int D = 1024, BATCH = 4, SEQ = 8192, NTOK = BATCH * SEQ, DEPTH = 4;
constexpr int NH = 8, HD = 64, VD = 128, QKVW = 3072;
constexpr int NE = 32, NG = 4, EPG = 8, DE = 512, NASG = NTOK * 2;
constexpr float ALPHA = 1.6817928305074290f;
constexpr float LN_EPS = 1e-5f, SUBLN_EPS = 1e-5f;
constexpr float QSCALE = 0.125f * 1.4426950408889634f;
constexpr int LIST_CAP = NTOK;

constexpr size_t MiB = 1u << 20;
constexpr size_t WS_CTL = 0, CTL_ZERO_BYTES = 1 * MiB;
constexpr size_t WS_ROPE = 1 * MiB, WS_RTW = 1 * MiB + 512 * 1024;
constexpr size_t WS_WQKV = 3 * MiB, WS_WO = 15 * MiB, WS_WIN = 19 * MiB, WS_WGRP = 23 * MiB, WS_WOUT = 24 * MiB;
constexpr size_t WS_WGU = 28 * MiB, WS_WD = 92 * MiB;
constexpr size_t WS_LTOK = 124 * MiB, WS_GATEW = 128 * MiB, WS_O0S = 129 * MiB;
constexpr size_t WS_HB = 162 * MiB, WS_Q = 226 * MiB, WS_K = 290 * MiB, WS_V = 354 * MiB, WS_O = 418 * MiB, WS_Y = 482 * MiB, WS_WGU2 = 610 * MiB, WS_WD2 = 674 * MiB, WS_END = 706 * MiB;
static_assert(WS_V - WS_K == WS_K - WS_Q, "Q|K|V equally spaced");
constexpr size_t WS_T = WS_Y;
constexpr size_t WS_STATS = WS_O0S + 16 * MiB;
constexpr size_t WS_ACT = WS_Q;
constexpr int CW_TMO = 0, CW_CODE = 1, CW_LAM = 512, CW_CNT = 1024  , CW_BAR = 8192;

typedef unsigned short bf16_t;
typedef float f32x4 __attribute__((ext_vector_type(4)));
typedef unsigned u32x4 __attribute__((ext_vector_type(4)));
typedef unsigned u32x2 __attribute__((ext_vector_type(2)));
#define LAS __attribute__((address_space(3)))

__device__ __forceinline__ float bf2f(bf16_t v) { return __uint_as_float((unsigned)v << 16); }
__device__ __forceinline__ unsigned f2bf(float f) { unsigned u = __float_as_uint(f); return (u + 0x7fffu + ((u >> 16) & 1u)) >> 16; }
__device__ __forceinline__ unsigned pk2(float lo, float hi) { return f2bf(lo) | (f2bf(hi) << 16); }
__device__ __forceinline__ unsigned cvt_pk_bf16(float lo, float hi) { typedef float f2 __attribute__((ext_vector_type(2))); typedef __bf16 b2 __attribute__((ext_vector_type(2))); f2 v = {lo, hi}; b2 b = __builtin_convertvector(v, b2); return __builtin_bit_cast(unsigned, b); }
__device__ __forceinline__ float wave_sum(float v) {
#pragma unroll
    for (int o = 1; o < 64; o <<= 1) v += __shfl_xor(v, o);
    return v;
}

struct Args {
    const float* in[21]; float* out; unsigned char* ws; int ph_lo, ph_hi;
};

namespace pg8 {
typedef short bf16x8 __attribute__((ext_vector_type(8)));
constexpr int BM = 256, BK = 64, HALF = 128, HTB = HALF * BK * 2, STAGE_BYTES = 8 * HTB, NXCD = 8, WGM = 8;
__device__ __forceinline__ int lds_byte(int r, int c) { const int st = (r >> 4) * 2 + (c >> 5), rr = r & 15, cc = c & 31, ob = rr * 64 + cc * 2; return st * 1024 + (ob ^ (((ob >> 9) & 1) << 5)); }
__device__ __forceinline__ void stage_rc(int b, int& R, int& C) { const int st = b / 1024, sb = b % 1024, swz = sb ^ (((sb >> 9) & 1) << 5); R = (st >> 1) * 16 + swz / 64; C = (st & 1) * 32 + (swz % 64) / 2; }
__device__ __forceinline__ int perm32(int rho) { const int n = rho >> 4, i = rho & 15; return 8 * (i >> 2) + 4 * n + (i & 3); }
struct Unit { int pm, pn, pnb, e, pos0, cnt, slot; };
struct Gemm { const bf16_t* A; const bf16_t* Bt; int lda, ldb, K, acol; };

struct StaticOrder {
    int nM, nN, nwg, G, c;
    __device__ void init(int M, int N, int G_, int c_) { nM = M / BM; nN = N / BM; nwg = nM * nN; G = G_; c = c_; }
    __device__ bool next(int i, Unit& u) const {
        const long L = (long)i * G + c; if (L >= nwg) return false;
        int wgid = (int)L; { const int q = nwg / NXCD, r = nwg % NXCD, xcd = wgid % NXCD, off = wgid / NXCD; wgid = (xcd < r ? xcd * (q + 1) : r * (q + 1) + (xcd - r) * q) + off; }
        const int nig = WGM * nN, gid = wgid / nig, fm = gid * WGM, gsz = (nM - fm) < WGM ? (nM - fm) : WGM;
        u.pm = fm + ((wgid % nig) % gsz); u.pn = (wgid % nig) / gsz; u.pnb = u.pn; u.e = 0; u.pos0 = 0; u.cnt = 0; u.slot = 0; return true;
    }
    __device__ __forceinline__ unsigned row_off(const Unit&, int) const { return 0u; }
};
struct MoeOrder {
    const LAS int* tstart; const LAS int* cntl; const LAS unsigned* tokoff; const LAS int* ue;
    int ntiles, G, c, ilo, ihi;
    __device__ bool find(int i, Unit& u) const {
        const int L = i * G + c; if (L >= ntiles * 4) return false;
        const int rt = (int)(L >> 2); u.pn = (int)(L & 3);
        int e = 0;
        for (int j = 1; j < NE; ++j) if (tstart[j] <= rt) e = j;
        u.e = e; u.pos0 = (rt - tstart[e]) * 256; u.cnt = cntl[e]; u.pm = rt; u.pnb = e * 4 + u.pn; u.slot = i; return true;
    }
    __device__ bool next(int i0, Unit& u) const {
        const int i = i0 + ilo; if (i >= ihi) return false;
        const int L = i * G + c; if (L >= ntiles * 4) return false;
        const int rt = L >> 2, e = ue[i]; u.pn = L & 3;
        u.e = e; u.pos0 = (rt - tstart[e]) * 256; u.cnt = cntl[e]; u.pm = rt; u.pnb = e * 4 + u.pn; u.slot = i; return true;
    }
    __device__ __forceinline__ unsigned row_off(const Unit& u, int row) const { return tokoff[u.slot * 256 + row]; }
};

typedef const f32x4 (&AccRef)[2][2][4][2];
struct EpiQKV {
    static constexpr bool PERM = true;
    bf16_t* Q; const float* rc; const float* rs;
    __device__ __forceinline__ void operator()(AccRef acc, const Unit& u, int wr, int wc, int fr, int fq) const {
        const int reg = u.pn >> 2; bf16_t* base = Q + (size_t)reg * ((WS_K - WS_Q) / 2);
        const int row0 = u.pm * BM + wr * 64 + fr, col0 = (u.pn & 3) * BM + wc * 32 + 8 * fq;
        const bool rope = (reg < 2) && ((wc & 1) == 0);
        const float sc = reg == 0 ? QSCALE : 1.f, sgn = fq == 0 ? -1.f : 1.f;
#pragma unroll
        for (int ai = 0; ai < 2; ++ai)
#pragma unroll
            for (int m = 0; m < 4; ++m) { const int row = row0 + ai * HALF + m * 16;
                f32x4 c0 = (f32x4){1.f, 1.f, 1.f, 1.f}, c1 = c0, s0 = (f32x4){0.f, 0.f, 0.f, 0.f}, s1 = s0;
                if (rope) { const int pos = row & (SEQ - 1); c0 = *(const f32x4*)(rc + pos * 8); c1 = *(const f32x4*)(rc + pos * 8 + 4); s0 = *(const f32x4*)(rs + pos * 8); s1 = *(const f32x4*)(rs + pos * 8 + 4); }
                const int bb = row >> 13, tile = (row & (SEQ - 1)) >> 6, r = row & 63;
#pragma unroll
                for (int bj = 0; bj < 2; ++bj) { f32x4 v0 = acc[ai][bj][m][0], v1 = acc[ai][bj][m][1];
                    if (rope) { f32x4 p0, p1;
#pragma unroll
                        for (int q = 0; q < 4; ++q) { p0[q] = __shfl_xor(v0[q], 16); p1[q] = __shfl_xor(v1[q], 16); }
                        const f32x4 r0 = v0 * c0 + p0 * s0 * sgn, r1 = v1 * c1 + p1 * s1 * sgn;
                        if (fq < 2) { v0 = r0; v1 = r1; } }
                    v0 = v0 * sc; v1 = v1 * sc;
                    u32x4 w; w.x = pk2(v0[0], v0[1]); w.y = pk2(v0[2], v0[3]); w.z = pk2(v1[0], v1[1]); w.w = pk2(v1[2], v1[3]);
                    const int col = col0 + bj * HALF;
                    size_t off;
                    if (reg == 0) off = (size_t)row * D + col;
                    else if (reg == 1) off = ((((size_t)(bb * NH + (col >> 7)) * 2 + ((col >> 6) & 1)) * (SEQ / 64) + tile) * 64 + r) * 64 + ((((col & 63) >> 3) ^ ((r >> 1) & 7)) << 3);
                    else off = ((((size_t)(bb * NH + (col >> 7)) * (SEQ / 64) + tile) * 4 + ((col & 127) >> 5)) * 4 + (r >> 4)) * 512 + (r & 15) * 32 + (col & 31);
                    *(u32x4*)(base + off) = w; } }
    }
};
struct EpiResid {
    static constexpr bool PERM = true;
    const float* HinF; const bf16_t* HinB; bf16_t* out; float* stats;
    typedef __attribute__((address_space(1))) const f32x4 gcf4; typedef __attribute__((address_space(1))) const u32x4 gcu4;
    typedef __attribute__((address_space(1))) u32x4 gu4; typedef float f32x2_t __attribute__((ext_vector_type(2))); typedef __attribute__((address_space(1))) f32x2_t gf2;
    __device__ __forceinline__ void operator()(AccRef acc, const Unit& u, int wr, int wc, int fr, int fq) const {
        const int row0 = u.pm * BM + wr * 64 + fr, col0 = u.pn * BM + wc * 32 + 8 * fq;
#pragma unroll
        for (int ai = 0; ai < 2; ++ai) {
            f32x4 hv[4][2][2];
            if (HinF) {
#pragma unroll
                for (int m = 0; m < 4; ++m)
#pragma unroll
                    for (int bj = 0; bj < 2; ++bj)
#pragma unroll
                        for (int n = 0; n < 2; ++n) hv[m][bj][n] = *(gcf4*)(HinF + (size_t)(row0 + ai * HALF + m * 16) * D + col0 + bj * HALF + n * 4);
            } else {
                u32x4 hw[4][2];
#pragma unroll
                for (int m = 0; m < 4; ++m)
#pragma unroll
                    for (int bj = 0; bj < 2; ++bj) hw[m][bj] = *(gcu4*)(HinB + (size_t)(row0 + ai * HALF + m * 16) * D + col0 + bj * HALF);
#pragma unroll
                for (int m = 0; m < 4; ++m)
#pragma unroll
                    for (int bj = 0; bj < 2; ++bj) { const u32x4 w = hw[m][bj];
                        hv[m][bj][0] = (f32x4){__uint_as_float(w.x << 16), __uint_as_float(w.x & 0xffff0000u), __uint_as_float(w.y << 16), __uint_as_float(w.y & 0xffff0000u)};
                        hv[m][bj][1] = (f32x4){__uint_as_float(w.z << 16), __uint_as_float(w.z & 0xffff0000u), __uint_as_float(w.w << 16), __uint_as_float(w.w & 0xffff0000u)}; }
            }
            float ps[4], pq[4];
#pragma unroll
            for (int m = 0; m < 4; ++m) { const size_t off = (size_t)(row0 + ai * HALF + m * 16) * D + col0; ps[m] = 0.f; pq[m] = 0.f;
#pragma unroll
                for (int bj = 0; bj < 2; ++bj) { const f32x4 t0 = hv[m][bj][0] * ALPHA + acc[ai][bj][m][0], t1 = hv[m][bj][1] * ALPHA + acc[ai][bj][m][1];
                    u32x4 w; w.x = cvt_pk_bf16(t0.x, t0.y); w.y = cvt_pk_bf16(t0.z, t0.w); w.z = cvt_pk_bf16(t1.x, t1.y); w.w = cvt_pk_bf16(t1.z, t1.w);
                    *(gu4*)(out + off + bj * HALF) = w;
                    ps[m] += ((t0.x + t0.y) + (t0.z + t0.w)) + ((t1.x + t1.y) + (t1.z + t1.w));
                    pq[m] += ((t0.x * t0.x + t0.y * t0.y) + (t0.z * t0.z + t0.w * t0.w)) + ((t1.x * t1.x + t1.y * t1.y) + (t1.z * t1.z + t1.w * t1.w)); } }
#pragma unroll
            for (int m = 0; m < 4; ++m) { ps[m] += __shfl_xor(ps[m], 16); pq[m] += __shfl_xor(pq[m], 16); }
#pragma unroll
            for (int m = 0; m < 4; ++m) { ps[m] += __shfl_xor(ps[m], 32); pq[m] += __shfl_xor(pq[m], 32); }
            if (fq == 0) {
#pragma unroll
                for (int m = 0; m < 4; ++m) *(gf2*)(stats + ((size_t)(row0 + ai * HALF + m * 16) * 16 + u.pn * 4 + wc) * 2) = (f32x2_t){ps[m], pq[m]}; }
        }
    }
};
struct EpiBf16S {
    static constexpr bool PERM = true;
    bf16_t* O; const float* ls;
    __device__ __forceinline__ void operator()(AccRef acc, const Unit& u, int wr, int wc, int fr, int fq) const {
        const int row0 = u.pm * BM + wr * 64 + fr, col0 = u.pn * BM + wc * 32 + 8 * fq;
        f32x4 sv[2][2];
#pragma unroll
        for (int bj = 0; bj < 2; ++bj)
#pragma unroll
            for (int n = 0; n < 2; ++n) sv[bj][n] = ls ? *(const f32x4*)(ls + col0 + bj * HALF + 4 * n) : (f32x4){1.f, 1.f, 1.f, 1.f};
#pragma unroll
        for (int ai = 0; ai < 2; ++ai)
#pragma unroll
            for (int m = 0; m < 4; ++m)
#pragma unroll
                for (int bj = 0; bj < 2; ++bj) { const f32x4 v0 = acc[ai][bj][m][0] * sv[bj][0], v1 = acc[ai][bj][m][1] * sv[bj][1];
                    u32x4 w; w.x = pk2(v0[0], v0[1]); w.y = pk2(v0[2], v0[3]); w.z = pk2(v1[0], v1[1]); w.w = pk2(v1[2], v1[3]);
                    *(u32x4*)(O + (size_t)(row0 + ai * HALF + m * 16) * D + col0 + bj * HALF) = w; }
    }
};
__device__ __forceinline__ float silu_mul(float g, float u) { return g * __builtin_amdgcn_rcpf(1.f + __expf(-g)) * u; }
struct EpiSwiGLU {
    static constexpr bool PERM = true;
    bf16_t* ACT;
    __device__ __forceinline__ void operator()(AccRef acc, const Unit& u, int wr, int wc, int fr, int fq) const {
        const int row0 = u.pm * BM + wr * 64 + fr, col0 = u.pn * HALF + wc * 32 + 8 * fq;
#pragma unroll
        for (int ai = 0; ai < 2; ++ai)
#pragma unroll
            for (int m = 0; m < 4; ++m) { const f32x4 g0 = acc[ai][0][m][0], g1 = acc[ai][0][m][1], u0 = acc[ai][1][m][0], u1 = acc[ai][1][m][1];
                u32x4 w; w.x = pk2(silu_mul(g0[0], u0[0]), silu_mul(g0[1], u0[1])); w.y = pk2(silu_mul(g0[2], u0[2]), silu_mul(g0[3], u0[3]));
                w.z = pk2(silu_mul(g1[0], u1[0]), silu_mul(g1[1], u1[1])); w.w = pk2(silu_mul(g1[2], u1[2]), silu_mul(g1[3], u1[3]));
                *(u32x4*)(ACT + (size_t)(row0 + ai * HALF + m * 16) * DE + col0) = w; }
    }
};
struct EpiScatter {
    static constexpr bool PERM = true;
    bf16_t* Y; const LAS int* destl; const LAS float* gwl;
    __device__ __forceinline__ void operator()(AccRef acc, const Unit& u, int wr, int wc, int fr, int fq) const {
        const int col0 = u.pn * BM + wc * 32 + 8 * fq;
#pragma unroll
        for (int ai = 0; ai < 2; ++ai)
#pragma unroll
            for (int m = 0; m < 4; ++m) { const int pl = ai * HALF + wr * 64 + m * 16 + fr; const int dest = destl[u.slot * 256 + pl]; const float gw = gwl[u.slot * 256 + pl];
                if (dest >= 0) {
#pragma unroll
                    for (int bj = 0; bj < 2; ++bj) { const f32x4 v0 = acc[ai][bj][m][0] * gw, v1 = acc[ai][bj][m][1] * gw;
                        u32x4 w; w.x = pk2(v0[0], v0[1]); w.y = pk2(v0[2], v0[3]); w.z = pk2(v1[0], v1[1]); w.w = pk2(v1[2], v1[3]);
                        *(u32x4*)(Y + (size_t)dest * D + col0 + bj * HALF) = w; } } }
    }
};

template <class Epi, class Sched, bool ALIGN_EPI, bool GATHER>
__device__ __forceinline__ void gemm_phase(LAS unsigned char* lds, const Gemm g, const Sched& S, const Epi& E, int tid) {
    asm volatile("" : "+v"(tid));
    const int wid = __builtin_amdgcn_readfirstlane(tid >> 6), lane = tid & 63, wr = wid >> 2, wc = wid & 3, fr = lane & 15, fq = lane >> 4;
    const int K = g.K, nt = K / BK;
    int Rr[2], Cc[2]; unsigned voffB[2];
#pragma unroll
    for (int i = 0; i < 2; ++i) { int R, C; stage_rc(tid * 16 + i * 8192, R, C); Rr[i] = R; Cc[i] = C; const int Rb = Epi::PERM ? ((R & ~31) + perm32(R & 31)) : R; voffB[i] = (unsigned)(Rb * g.ldb + C) * 2u; }
    const size_t kstep = (size_t)(BK * 2);
    const size_t hstepB = (size_t)HALF * g.ldb * 2;
    const unsigned hstepA = (unsigned)HALF * (unsigned)g.lda * 2u;
    const unsigned ldsw = (unsigned)wid * 1024u;
    const int aoff = lds_byte(wr * 64 + fr, fq * 8), boff = lds_byte(wc * 32 + fr, fq * 8);
    unsigned cvo[2][2], nvo[2][2];
#define PG8_SETVO(vo, u) do { _Pragma("unroll") for (int _h = 0; _h < 2; ++_h) _Pragma("unroll") for (int _i = 0; _i < 2; ++_i) \
        vo[_h][_i] = GATHER ? (S.row_off(u, Rr[_i] + HALF * _h) + (unsigned)Cc[_i] * 2u) : ((unsigned)(Rr[_i] * g.lda + Cc[_i]) * 2u + (unsigned)_h * hstepA); } while (0)
#define PG8_UA(u) (GATHER ? (const char*)g.A : (const char*)g.A + ((size_t)(u).pm * BM * g.lda + (size_t)(u).pn * g.acol) * 2)
#define PG8_UB(u) ((const char*)g.Bt + (size_t)(u).pnb * BM * g.ldb * 2)
#define PG8_SA(b, h) (((b) * 2 + (h)) * HTB)
#define PG8_SB(b, h) ((4 + (b) * 2 + (h)) * HTB)
#define PG8_STB(bufoff, gbase) do { _Pragma("unroll") for (int _i = 0; _i < 2; ++_i) \
        __builtin_amdgcn_global_load_lds((const unsigned*)((const char*)(gbase) + voffB[_i]), (LAS unsigned*)(lds + (bufoff) + ldsw + _i * 8192), 16, 0, 0); } while (0)
#define PG8_STA(bufoff, gbase, H, NX) do { _Pragma("unroll") for (int _i = 0; _i < 2; ++_i) { const unsigned _o = (GATHER && (NX)) ? nvo[H][_i] : cvo[H][_i]; \
        __builtin_amdgcn_global_load_lds((const unsigned*)((const char*)(gbase) + _o), (LAS unsigned*)(lds + (bufoff) + ldsw + _i * 8192), 16, 0, 0); } } while (0)
#define PG8_LDA(dst, b, h) do { _Pragma("unroll") for (int m = 0; m < 4; ++m) _Pragma("unroll") for (int k = 0; k < 2; ++k) dst[m][k] = *(const LAS bf16x8*)(lds + PG8_SA(b, h) + aoff + m * 2048 + k * 1024); } while (0)
#define PG8_LDB(dst, b, h) do { _Pragma("unroll") for (int n = 0; n < 2; ++n) _Pragma("unroll") for (int k = 0; k < 2; ++k) dst[n][k] = *(const LAS bf16x8*)(lds + PG8_SB(b, h) + boff + n * 2048 + k * 1024); } while (0)
#define PG8_MMA(ai, bj, At, Bt) do { __builtin_amdgcn_s_setprio(1); _Pragma("unroll") for (int m = 0; m < 4; ++m) _Pragma("unroll") for (int n = 0; n < 2; ++n) _Pragma("unroll") for (int k = 0; k < 2; ++k) \
        acc[ai][bj][m][n] = __builtin_amdgcn_mfma_f32_16x16x32_bf16(Bt[n][k], At[m][k], acc[ai][bj][m][n], 0, 0, 0); __builtin_amdgcn_s_setprio(0); } while (0)
#define PG8_WAIT_V(n) asm volatile("s_waitcnt vmcnt(" #n ")" ::: "memory")
#define PG8_WAIT_L(n) asm volatile("s_waitcnt lgkmcnt(" #n ")" ::: "memory")
#define PG8_BAR __builtin_amdgcn_s_barrier()
#define PG8_SCHED __builtin_amdgcn_sched_barrier(0)
    Unit cur, nxt; int ui = 0;
    if (!S.next(0, cur)) return;
    f32x4 acc[2][2][4][2];
#pragma unroll
    for (int a = 0; a < 2; ++a)
#pragma unroll
        for (int b = 0; b < 2; ++b)
#pragma unroll
            for (int m = 0; m < 4; ++m)
#pragma unroll
                for (int n = 0; n < 2; ++n) acc[a][b][m][n] = (f32x4){0.f, 0.f, 0.f, 0.f};
    bf16x8 At[4][2], B0[2][2], B1[2][2];
    const char* cA = PG8_UA(cur); const char* cB = PG8_UB(cur);
    PG8_SETVO(cvo, cur);
#pragma unroll
    for (int _h = 0; _h < 2; ++_h)
#pragma unroll
        for (int _i = 0; _i < 2; ++_i) nvo[_h][_i] = cvo[_h][_i];
    PG8_STB(PG8_SB(0, 0), cB); PG8_STB(PG8_SB(0, 1), cB + hstepB); PG8_STA(PG8_SA(0, 0), cA, 0, false); PG8_STA(PG8_SA(0, 1), cA, 1, false);
    if (wr == 1) PG8_BAR;
    PG8_WAIT_V(2); PG8_BAR;
    PG8_STB(PG8_SB(1, 0), cB + kstep); PG8_STA(PG8_SA(1, 0), cA + kstep, 0, false); PG8_STB(PG8_SB(1, 1), cB + hstepB + kstep);
    PG8_WAIT_V(6); PG8_BAR;
    for (;;) {
        const bool has_next = S.next(ui + 1, nxt);
        const char* nA = has_next ? PG8_UA(nxt) : cA; const char* nB = has_next ? PG8_UB(nxt) : cB;
        if (GATHER) { if (has_next) { PG8_SETVO(nvo, nxt); } }
        for (int t = 0; t < nt; t += 2) {
            const bool last = (t == nt - 2);
            const char* a1 = cA + (size_t)(t + 1) * kstep;
            const char* a2 = last ? nA : cA + (size_t)(t + 2) * kstep; const char* b2 = last ? nB : cB + (size_t)(t + 2) * kstep;
            const char* a3 = a2 + kstep; const char* b3 = b2 + kstep;
            __builtin_amdgcn_s_setprio(1); PG8_LDB(B0, 0, 0); PG8_LDB(B1, 0, 1); PG8_SCHED; PG8_LDA(At, 0, 0); __builtin_amdgcn_s_setprio(0); PG8_STA(PG8_SA(1, 1), a1, 1, false);
            PG8_WAIT_V(8); PG8_WAIT_L(0); PG8_BAR; PG8_MMA(0, 0, At, B0); PG8_MMA(0, 1, At, B1); PG8_BAR; PG8_SCHED;
            __builtin_amdgcn_s_setprio(1); PG8_LDA(At, 0, 1); __builtin_amdgcn_s_setprio(0); PG8_STB(PG8_SB(0, 0), b2); PG8_STB(PG8_SB(0, 1), b2 + hstepB); PG8_STA(PG8_SA(0, 0), a2, 0, last);
            PG8_WAIT_V(8); PG8_WAIT_L(0); PG8_BAR; PG8_MMA(1, 0, At, B0); PG8_MMA(1, 1, At, B1); PG8_BAR; PG8_SCHED;
            __builtin_amdgcn_s_setprio(1); PG8_LDB(B0, 1, 0); PG8_LDB(B1, 1, 1); PG8_SCHED; PG8_LDA(At, 1, 0); __builtin_amdgcn_s_setprio(0); PG8_STA(PG8_SA(0, 1), a2, 1, last);
            PG8_WAIT_V(8); PG8_WAIT_L(0); PG8_BAR; PG8_MMA(0, 0, At, B0); PG8_MMA(0, 1, At, B1); PG8_BAR; PG8_SCHED;
            __builtin_amdgcn_s_setprio(1); PG8_LDA(At, 1, 1); __builtin_amdgcn_s_setprio(0); PG8_STB(PG8_SB(1, 0), b3); PG8_STB(PG8_SB(1, 1), b3 + hstepB); PG8_STA(PG8_SA(1, 0), a3, 0, last);
            PG8_WAIT_V(8); PG8_WAIT_L(0); PG8_BAR; PG8_MMA(1, 0, At, B0); PG8_MMA(1, 1, At, B1); PG8_BAR; PG8_SCHED;
        }
        if constexpr (ALIGN_EPI) { if (wr == 0) PG8_BAR; }
        E(acc, cur, wr, wc, fr, fq);
        if (!has_next) break;
#pragma unroll
        for (int a = 0; a < 2; ++a)
#pragma unroll
            for (int b = 0; b < 2; ++b)
#pragma unroll
                for (int m = 0; m < 4; ++m)
#pragma unroll
                    for (int n = 0; n < 2; ++n) acc[a][b][m][n] = (f32x4){0.f, 0.f, 0.f, 0.f};
        cur = nxt; cA = nA; cB = nB; ++ui;
#pragma unroll
        for (int _h = 0; _h < 2; ++_h)
#pragma unroll
            for (int _i = 0; _i < 2; ++_i) cvo[_h][_i] = nvo[_h][_i];
        if constexpr (ALIGN_EPI) { if (wr == 1) PG8_BAR; }
    }
    PG8_WAIT_V(0);
    if constexpr (!ALIGN_EPI) { if (wr == 0) PG8_BAR; }
    PG8_BAR;
#undef PG8_SETVO
#undef PG8_UA
#undef PG8_UB
#undef PG8_SA
#undef PG8_SB
#undef PG8_STA
#undef PG8_STB
#undef PG8_LDA
#undef PG8_LDB
#undef PG8_MMA
#undef PG8_WAIT_V
#undef PG8_WAIT_L
#undef PG8_BAR
#undef PG8_SCHED
}
}

namespace att {
typedef short bf16x8 __attribute__((ext_vector_type(8)));
typedef short s16x4 __attribute__((ext_vector_type(4)));
typedef float f32x16 __attribute__((ext_vector_type(16)));
constexpr int KSLOT = 8192, VSLOT = 16384, NSLOT = 3;
constexpr float BIGP = 1048576.f;
constexpr int L_K = 0, L_V = NSLOT * KSLOT, L_WS = L_V + NSLOT * VSLOT, L_Q = L_WS + 8 * 64 * 4, L_END = L_Q + 8 * 4096;
__device__ __forceinline__ int crow(int r, int hi) { return (r & 3) + 8 * (r >> 2) + 4 * hi; }
__device__ __forceinline__ s16x4 vtr(const LAS unsigned char* p) { typedef short v4i16_t __attribute__((ext_vector_type(4))); return __builtin_bit_cast(s16x4, __builtin_amdgcn_ds_read_tr16_b64_v4i16((LAS v4i16_t*)p)); }
__device__ __forceinline__ float swap_max(float m) { auto rr = __builtin_amdgcn_permlane32_swap(__float_as_uint(m), __float_as_uint(m), false, false); return fmaxf(__uint_as_float(rr[0]), __uint_as_float(rr[1])); }
__device__ __forceinline__ float swap_sum(float m) { auto rr = __builtin_amdgcn_permlane32_swap(__float_as_uint(m), __float_as_uint(m), false, false); return __uint_as_float(rr[0]) + __uint_as_float(rr[1]); }
__device__ __forceinline__ unsigned cvtpk(float lo, float hi) { typedef float f2 __attribute__((ext_vector_type(2))); typedef __bf16 b2 __attribute__((ext_vector_type(2))); f2 v = {lo, hi}; b2 b = __builtin_convertvector(v, b2); return __builtin_bit_cast(unsigned, b); }

__device__ __forceinline__ float max3f(float a, float b, float c) { float r; asm("v_max3_f32 %0, %1, %2, %3" : "=v"(r) : "v"(a), "v"(b), "v"(c)); return r; }
__device__ __forceinline__ void glds16(const char* sbase, unsigned voff, unsigned lds_dst) { unsigned keep;
    asm volatile("s_mov_b32 %0, m0\n\ts_mov_b32 m0, %3\n\ts_nop 0\n\tglobal_load_lds_dwordx4 %2, %1\n\ts_mov_b32 m0, %0" : "=&s"(keep) : "s"(sbase), "v"(voff), "s"(lds_dst) : "memory"); }
struct Tensors { const bf16_t* Q; const bf16_t* K; const bf16_t* V; bf16_t* O; float* o0s; const float* subg; float lam, oml; };

__device__ __forceinline__ void attn_unit(int b, int h, int qb, const Tensors& T, LAS unsigned char* lds, int tid, int bx) {
    const int lane = tid & 63, r32 = lane & 31, hi = lane >> 5, wid = __builtin_amdgcn_readfirstlane(tid >> 6);
    const size_t rowbase = (size_t)b * SEQ; const int q0 = qb * 256, NT = (q0 + 256) / 64;
    const int qrow = q0 + wid * 32 + r32, wave_qmin = q0 + wid * 32, wave_qmax = wave_qmin + 31;
    LAS float* wsf = (LAS float*)(lds + L_WS) + wid * 64;
    const unsigned lds0 = (unsigned)(uintptr_t)lds;
    const int kx = (r32 >> 1) & 7;
    const LAS unsigned char* kp0 = lds + L_K + r32 * 128 + ((hi ^ (kx & 1)) << 4) + ((kx >> 1) << 5);
    const LAS unsigned char* vp0 = lds + L_V + ((lane >> 4) & 1) * 32 + (lane & 3) * 8 + (4 * hi + ((lane & 15) >> 2)) * 64;
#define SB() __builtin_amdgcn_sched_barrier(0)
#define MF(a, b, c) __builtin_amdgcn_mfma_f32_32x32x16_bf16(a, b, c, 0, 0, 0)
    for (int map = 0; map < 2; ++map) {
        const char* qbase = (const char*)(T.Q + (rowbase + q0 + wid * 32) * D + h * 128 + map * 64);
        const char* kbase = (const char*)(T.K + ((size_t)((b * NH + h) * 2 + map) * (SEQ / 64)) * 4096 + wid * 512);
        const char* vbase = (const char*)(T.V + ((size_t)(b * NH + h) * (SEQ / 64)) * 8192 + wid * 512);
        const unsigned koff = (unsigned)lane * 16u, voff = koff;
#define DMA_K(t, slot) glds16(kbase + (size_t)(t) * 8192, koff, (unsigned)__builtin_amdgcn_readfirstlane((int)(lds0 + L_K + (slot) * KSLOT + wid * 1024)))
#define DMA_V0(t, slot) glds16(vbase + (size_t)(t) * 16384, voff, (unsigned)__builtin_amdgcn_readfirstlane((int)(lds0 + L_V + (slot) * VSLOT + wid * 1024)))
#define DMA_V1(t, slot) glds16(vbase + (size_t)(t) * 16384 + 8192, voff, (unsigned)__builtin_amdgcn_readfirstlane((int)(lds0 + L_V + (slot) * VSLOT + (wid + 8) * 1024)))
#define DMA_V(t, slot) do { DMA_V0(t, slot); DMA_V1(t, slot); } while (0)
#define KLD(i, kp) kf[i] = *(const LAS bf16x8*)((const LAS unsigned char*)((unsigned)(uintptr_t)(kp) ^ (unsigned)(((i) >> 1) << 5)) + ((i) & 1) * 4096)
#define VRD(i, vp) do { vlo[(i) & 7] = vtr((vp) + ((i) >> 2) * 4096 + ((i) & 3) * 1024); vhi[(i) & 7] = vtr((vp) + ((i) >> 2) * 4096 + ((i) & 3) * 1024 + 512); } while (0)
#define VFR(i) ((bf16x8){vlo[(i) & 7][0], vlo[(i) & 7][1], vlo[(i) & 7][2], vlo[(i) & 7][3], vhi[(i) & 7][0], vhi[(i) & 7][1], vhi[(i) & 7][2], vhi[(i) & 7][3]})
#define EXP2S(i) do { if ((i) < 8) { S0[2 * (i)] = __builtin_amdgcn_exp2f(S0[2 * (i)]); S0[2 * (i) + 1] = __builtin_amdgcn_exp2f(S0[2 * (i) + 1]); \
                          if ((i) > 0) { sacc += S0[2 * (i) - 2]; sacc += S0[2 * (i) - 1]; } asm volatile("" : "+v"(S0), "+v"(sacc)); } \
                      else { S1[2 * (i) - 16] = __builtin_amdgcn_exp2f(S1[2 * (i) - 16]); S1[2 * (i) - 15] = __builtin_amdgcn_exp2f(S1[2 * (i) - 15]); \
                          if ((i) == 8) { sacc += S0[14]; sacc += S0[15]; } else { sacc += S1[2 * (i) - 18]; sacc += S1[2 * (i) - 17]; } asm volatile("" : "+v"(S1), "+v"(sacc)); } } while (0)
#define QK_PLAIN() do { const bf16x8 q0_ = QF(0), q1_ = QF(1), q2_ = QF(2), q3_ = QF(3); S0 = MF(kf[0], q0_, zero16); S1 = MF(kf[1], q0_, zero16); S0 = MF(kf[2], q1_, S0); S1 = MF(kf[3], q1_, S1); \
        S0 = MF(kf[4], q2_, S0); S1 = MF(kf[5], q2_, S1); S0 = MF(kf[6], q3_, S0); S1 = MF(kf[7], q3_, S1); } while (0)
#define MASK(t) do { if (64 * (t) + 63 > wave_qmin) { const int kb_ = 64 * (t) + 4 * hi; \
        _Pragma("unroll") for (int r = 0; r < 16; ++r) { const int kv_ = kb_ + (r & 3) + 8 * (r >> 2); if (kv_ > qrow) S0[r] = -INFINITY; if (kv_ + 32 > qrow) S1[r] = -INFINITY; } } } while (0)
#define ROWMAX(rm) do { asm volatile("s_nop 15\n\ts_nop 7" : "+v"(S0), "+v"(S1)); \
        float a_ = max3f(S0[0], S0[1], S1[0]), b_ = max3f(S0[2], S0[3], S1[1]); a_ = max3f(a_, S1[2], S1[3]); \
        _Pragma("unroll") for (int r = 4; r < 16; r += 4) { a_ = max3f(a_, S0[r], S0[r + 1]); b_ = max3f(b_, S0[r + 2], S0[r + 3]); a_ = max3f(a_, S1[r], S1[r + 1]); b_ = max3f(b_, S1[r + 2], S1[r + 3]); } \
        rm = swap_max(max3f(a_, b_, b_)); } while (0)
#define SUMPACK_FULL() do { float sum_ = 0.f; _Pragma("unroll") for (int r = 0; r < 16; ++r) sum_ += S0[r] + S1[r]; l_run += sum_; PACK(); } while (0)
#define PACK() do { \
        pa[0] = (u32x4){cvtpk(S0[0], S0[1]), cvtpk(S0[2], S0[3]), cvtpk(S0[4], S0[5]), cvtpk(S0[6], S0[7])}; pa[1] = (u32x4){cvtpk(S0[8], S0[9]), cvtpk(S0[10], S0[11]), cvtpk(S0[12], S0[13]), cvtpk(S0[14], S0[15])}; \
        pa[2] = (u32x4){cvtpk(S1[0], S1[1]), cvtpk(S1[2], S1[3]), cvtpk(S1[4], S1[5]), cvtpk(S1[6], S1[7])}; pa[3] = (u32x4){cvtpk(S1[8], S1[9]), cvtpk(S1[10], S1[11]), cvtpk(S1[12], S1[13]), cvtpk(S1[14], S1[15])}; } while (0)
#define PAF(k) __builtin_bit_cast(bf16x8, pa[k])
        DMA_K(0, 0); DMA_V(0, 0); DMA_K(1, 1); DMA_K(2, 2);
        bf16x8 kf[8];
        bf16x8 qr[4];
#pragma unroll
        for (int d0 = 0; d0 < 4; ++d0) qr[d0] = *(const bf16x8*)(qbase + (unsigned)(r32 * D + d0 * 16 + hi * 8) * 2u);
#define QF(d0) qr[d0]
        float m_run = 0.f, l_run = 0.f;
        f32x16 o[4], S0, S1; u32x4 pa[4]; const f32x16 zero16 = {0.f, 0.f, 0.f, 0.f, 0.f, 0.f, 0.f, 0.f, 0.f, 0.f, 0.f, 0.f, 0.f, 0.f, 0.f, 0.f}; s16x4 vlo[8], vhi[8];
#pragma unroll
        for (int d = 0; d < 4; ++d)
#pragma unroll
            for (int r = 0; r < 16; ++r) o[d][r] = 0.f;
        asm volatile("s_waitcnt vmcnt(4)" ::: "memory"); __builtin_amdgcn_s_barrier();
#pragma unroll
        for (int i = 0; i < 8; ++i) KLD(i, kp0);
        QK_PLAIN(); MASK(0);
        f32x16 negm;
        { float rm; ROWMAX(rm); m_run = rm;
#pragma unroll
          for (int r = 0; r < 16; ++r) negm[r] = -rm;
#pragma unroll
          for (int r = 0; r < 16; ++r) { S0[r] = __builtin_amdgcn_exp2f(S0[r] - rm); S1[r] = __builtin_amdgcn_exp2f(S1[r] - rm); } }
        SUMPACK_FULL();
        asm volatile("s_waitcnt vmcnt(0) lgkmcnt(0)" ::: "memory"); __builtin_amdgcn_s_barrier();
        DMA_K(3, 0); DMA_V(1, 1);
#pragma unroll
        for (int i = 0; i < 8; ++i) KLD(i, kp0 + KSLOT);
        asm volatile("s_waitcnt lgkmcnt(0)" ::: "memory"); __builtin_amdgcn_s_barrier();
        int s0 = 0, s1 = 1, s2 = 2;
#define GAPB(i, QKF, LDKF) do { o[(i) >> 2] = MF(PAF((i) & 3), VFR(i), o[(i) >> 2]); if (QKF) EXP2S(i); if ((i) < 8) { VRD((i) + 8, vp); if (LDKF) KLD(i, kpn); } SB(); } while (0)
#define ITER(QKF, PVF, LDKF, MSKF) do { \
            const LAS unsigned char* vp = vp0 + s0 * VSLOT; const LAS unsigned char* kpn = kp0 + s2 * KSLOT; \
            SB(); \
            if (QKF && PVF) { \
                const bf16x8 q0_ = QF(0), q1_ = QF(1), q2_ = QF(2), q3_ = QF(3); SB(); \
                VRD(0, vp); SB(); S0 = MF(kf[0], q0_, negm); SB(); if (t + 3 < NT) DMA_K(t + 3, s1); VRD(1, vp); SB(); S1 = MF(kf[1], q0_, negm); SB(); \
                VRD(2, vp); SB(); S0 = MF(kf[2], q1_, S0); SB(); if (t + 1 < NT) DMA_V0(t + 1, s2); VRD(3, vp); SB(); S1 = MF(kf[3], q1_, S1); SB(); \
                VRD(4, vp); SB(); S0 = MF(kf[4], q2_, S0); SB(); if (t + 1 < NT) DMA_V1(t + 1, s2); VRD(5, vp); SB(); S1 = MF(kf[5], q2_, S1); SB(); \
                VRD(6, vp); SB(); S0 = MF(kf[6], q3_, S0); SB(); VRD(7, vp); SB(); S1 = MF(kf[7], q3_, S1); SB(); \
            } else { if (PVF) { VRD(0, vp); VRD(1, vp); VRD(2, vp); VRD(3, vp); VRD(4, vp); VRD(5, vp); VRD(6, vp); VRD(7, vp); SB(); } \
                if (t + 3 < NT) DMA_K(t + 3, s1); \
                if (t + 1 < NT) DMA_V(t + 1, s2); } \
            float sacc = 0.f; \
            if (QKF && MSKF) MASK(t); \
            SB(); \
            if (PVF) { \
                GAPB(0, QKF, LDKF); GAPB(1, QKF, LDKF); GAPB(2, QKF, LDKF); GAPB(3, QKF, LDKF); GAPB(4, QKF, LDKF); GAPB(5, QKF, LDKF); GAPB(6, QKF, LDKF); GAPB(7, QKF, LDKF); \
                GAPB(8, QKF, LDKF); GAPB(9, QKF, LDKF); GAPB(10, QKF, LDKF); GAPB(11, QKF, LDKF); GAPB(12, QKF, LDKF); GAPB(13, QKF, LDKF); GAPB(14, QKF, LDKF); GAPB(15, QKF, LDKF); \
            } \
            if (QKF) { \
                sacc += S1[14]; sacc += S1[15]; \
                if (__any(sacc > BIGP)) { \
                    const float sm = swap_max(sacc); \
                    const float e_ = (sm > BIGP) ? ceilf(__builtin_amdgcn_logf(sm)) : 0.f; const float fsc = __builtin_amdgcn_exp2f(-e_); \
                    m_run += e_; l_run *= fsc; sacc *= fsc; \
                    _Pragma("unroll") for (int r = 0; r < 16; ++r) negm[r] = -m_run; \
                    _Pragma("unroll") for (int r = 0; r < 16; ++r) { S0[r] *= fsc; S1[r] *= fsc; } \
                    if (hi == 0) wsf[r32] = fsc; \
                    asm volatile("s_waitcnt lgkmcnt(0)" ::: "memory"); \
                    _Pragma("unroll") for (int r = 0; r < 16; ++r) { const float fr = wsf[crow(r, hi)]; \
                        _Pragma("unroll") for (int d = 0; d < 4; ++d) o[d][r] *= fr; } \
                } \
                l_run += sacc; PACK(); \
            } \
        } while (0)
#define CLOSE() do { if (t + 3 < NT) asm volatile("s_waitcnt vmcnt(3) lgkmcnt(0)" ::: "memory"); \
            else if (t + 1 < NT) asm volatile("s_waitcnt vmcnt(2) lgkmcnt(0)" ::: "memory"); \
            else asm volatile("s_waitcnt vmcnt(0) lgkmcnt(0)" ::: "memory"); \
            __builtin_amdgcn_s_barrier(); { const int tmp = s0; s0 = s1; s1 = s2; s2 = tmp; } } while (0)
        int t = 1;
        for (; t < NT - 4; ++t) { ITER(1, 1, 1, 0); CLOSE(); }
        const int t_last = wave_qmax >> 6;
        for (; t <= t_last; ++t) { ITER(1, 1, 1, 1); CLOSE(); }
        { ITER(0, 1, 0, 0); CLOSE(); ++t; }
        for (; t <= NT; ++t) { ITER(0, 0, 0, 0); CLOSE(); }
#undef GAPB
#undef ITER
#undef CLOSE
#undef DMA_K
#undef DMA_V
#undef DMA_V0
#undef DMA_V1
#undef KLD
#undef VRD
#undef VFR
#undef EXP2S
#undef QK_PLAIN
#undef QF
#undef MASK
#undef ROWMAX
#undef SUMPACK_FULL
#undef PACK
#undef PAF
        const float lt = swap_sum(l_run);
        if (hi == 0) wsf[32 + r32] = lt;
        asm volatile("s_waitcnt lgkmcnt(0)" ::: "memory");
#pragma unroll
        for (int r = 0; r < 16; ++r) { const float il = __builtin_amdgcn_rcpf(wsf[32 + crow(r, hi)]);
#pragma unroll
            for (int d = 0; d < 4; ++d) o[d][r] *= il; }
        int lane2 = lane; asm volatile("" : "+v"(lane2));
        float* o0p = T.o0s + ((size_t)(bx * 8 + wid) * 64) * 64 + (unsigned)lane2;
        if (map == 0) {
#pragma unroll
            for (int d = 0; d < 4; ++d)
#pragma unroll
                for (int r = 0; r < 16; ++r) o0p[(d * 16 + r) * 64] = o[d][r];
        } else {
            float sg[4], rs[16];
#pragma unroll
            for (int d = 0; d < 4; ++d) sg[d] = T.subg[32 * d + (lane2 & 31)] * T.oml;
#pragma unroll
            for (int r = 0; r < 16; ++r) {
                float ss = 0.f;
#pragma unroll
                for (int d = 0; d < 4; ++d) { const float v = o0p[(d * 16 + r) * 64] - T.lam * o[d][r]; o[d][r] = v; ss += v * v; }
                ss += __shfl_xor(ss, 1); ss += __shfl_xor(ss, 2); ss += __shfl_xor(ss, 4); ss += __shfl_xor(ss, 8); ss += __shfl_xor(ss, 16);
                rs[r] = __builtin_amdgcn_rsqf(ss * (1.f / 128.f) + SUBLN_EPS);
            }
            LAS bf16_t* stg = (LAS bf16_t*)(lds + L_Q + wid * 4096);
            bf16_t* Ow = T.O + (rowbase + q0 + wid * 32) * D + h * 128;
#pragma unroll
            for (int hp = 0; hp < 2; ++hp) {
#pragma unroll
                for (int r = 0; r < 16; ++r)
#pragma unroll
                    for (int dd = 0; dd < 2; ++dd) stg[crow(r, hi) * 64 + dd * 32 + r32] = (bf16_t)f2bf(o[2 * hp + dd][r] * rs[r] * sg[2 * hp + dd]);
                asm volatile("s_waitcnt lgkmcnt(0)" ::: "memory");
#pragma unroll
                for (int i = 0; i < 4; ++i) { const int row = i * 8 + (lane2 >> 3), ch = lane2 & 7;
                    const u32x4 v = *(const LAS u32x4*)(stg + row * 64 + ch * 8); *(u32x4*)(Ow + (size_t)row * D + hp * 64 + ch * 8) = v; }
                asm volatile("s_waitcnt lgkmcnt(0)" ::: "memory");
            }
        }
        asm volatile("s_waitcnt lgkmcnt(0)" ::: "memory");
        __builtin_amdgcn_s_barrier();
    }
#undef SB
#undef MF
}
__device__ __forceinline__ void attn_phase(LAS unsigned char* lds, const Tensors& T, int G, int vcu, int bx, int tid) {
    asm volatile("" : "+v"(tid));
    const int nun = (G == 256) ? 4 : (BATCH * NH * (SEQ / 256) - vcu + G - 1) / G;
    for (int i = 0; i < nun; ++i) {
        int bh, qb;
        if (G == 256) { const int s = vcu & 7; bh = vcu >> 3; qb = (i == 0) ? s : (i == 1) ? 15 - s : (i == 2) ? 16 + s : 31 - s; }
        else { const int u = vcu + i * G; bh = u >> 5; qb = u & 31; }
        attn_unit(bh >> 3, bh & 7, qb, T, lds, tid, bx);
    }
}
}

#define XB_TMO      128
#define XB_XCNT(j)  (256  + 64 * (j))
#define XB_XSUB(j)  (1280 + 64 * (j))
#define XB_XGEN(j)  (2304 + 64 * (j))
#define XB_TOP      3328
#define XB_TOPGEN   3392
#define XCD_BAR_WORDS 3456
#define XB_SPIN_CAP (1u << 18)
__device__ __forceinline__ unsigned xb_ld(unsigned* p)              { return __hip_atomic_load(p, __ATOMIC_RELAXED, __HIP_MEMORY_SCOPE_AGENT); }
__device__ __forceinline__ unsigned xb_add(unsigned* p, unsigned v) { return __hip_atomic_fetch_add(p, v, __ATOMIC_RELAXED, __HIP_MEMORY_SCOPE_AGENT); }
__device__ __forceinline__ unsigned xb_xcc_id() { return (unsigned)__builtin_amdgcn_s_getreg((3 << 11) | 20) & 0xFu; }
#define XB_SPIN(cond, bar) do { unsigned _sp = 0; while (cond) { __builtin_amdgcn_s_sleep(1); \
    if ((++_sp & 255u) == 0u) { if (xb_ld(&(bar)[XB_TMO])) break; if (_sp > XB_SPIN_CAP) { atomicAdd(&(bar)[XB_TMO], 1u); break; } } } } while (0)
struct XcdBarrier { unsigned* bar; unsigned x; volatile LAS unsigned* st; };
__device__ __forceinline__ XcdBarrier xcd_barrier_post(unsigned* bar, volatile LAS unsigned* st, bool t0  ) {
    XcdBarrier b; b.bar = bar; b.x = xb_xcc_id(); b.st = st;
    if (t0) (void)xb_add(&bar[XB_XCNT(b.x)], 1u);
    return b;
}
__device__ __forceinline__ void xcd_barrier_complete(unsigned* bar, unsigned x, unsigned& nloc, unsigned& nx) {
    const unsigned G = gridDim.x * gridDim.y * gridDim.z;
    unsigned sum, cnt, mine, sp = 0u;
    for (;;) {
        sum = 0u; cnt = 0u; mine = 0u;
#pragma unroll
        for (unsigned j = 0; j < 16; ++j) { const unsigned c = xb_ld(&bar[XB_XCNT(j)]); sum += c; cnt += (c > 0u) ? 1u : 0u; mine = (j == x) ? c : mine; }
        if (sum == G) break;
        __builtin_amdgcn_s_sleep(1);
        if ((++sp & 255u) == 0u) { if (xb_ld(&bar[XB_TMO])) break; if (sp > XB_SPIN_CAP) { atomicAdd(&bar[XB_TMO], 1u); break; } }
    }
    nloc = mine > 0u ? mine : 1u; nx = cnt > 0u ? cnt : 1u;
}
__device__ __forceinline__ void xcd_barrier(const XcdBarrier& b, bool t0  ) {
    asm volatile("s_waitcnt vmcnt(0)" ::: "memory");
    __syncthreads();
    if (t0) {
        unsigned* bar = b.bar;
        __builtin_amdgcn_s_waitcnt(0);
        unsigned nloc = b.st[0], nx = b.st[1];
        if (nloc == 0u) { xcd_barrier_complete(bar, b.x, nloc, nx); b.st[0] = nloc; b.st[1] = nx; }
        const unsigned old = xb_add(&bar[XB_XSUB(b.x)], 1u);
        const unsigned gen = old / nloc;
        if (old + 1u == (gen + 1u) * nloc) {
            __builtin_amdgcn_fence(__ATOMIC_RELEASE, "agent");
            asm volatile("s_waitcnt vmcnt(0)" ::: "memory");
            const unsigned og = xb_add(&bar[XB_TOP], 1u);
            const unsigned tg = og / nx;
            if (og + 1u == (tg + 1u) * nx) xb_add(&bar[XB_TOPGEN], 1u);
            else XB_SPIN(xb_ld(&bar[XB_TOPGEN]) == tg, bar);
            __builtin_amdgcn_fence(__ATOMIC_ACQUIRE, "agent");
            xb_add(&bar[XB_XGEN(b.x)], 1u);
            asm volatile("s_waitcnt vmcnt(0)" ::: "memory");
        } else {
            XB_SPIN(xb_ld(&bar[XB_XGEN(b.x)]) == gen, bar);
            __builtin_amdgcn_fence(__ATOMIC_ACQUIRE, "agent");
            asm volatile("s_waitcnt vmcnt(0)" ::: "memory");
        }
    }
    __syncthreads();
}

constexpr int NWAVES = 8, LDS_BYTES = 147456;
struct Frame {
    LAS unsigned char* lds; unsigned* ctl; int tid, lane, wave, G, gw, NGW, bx, vcu;
    float* out; unsigned char* ws;
};

constexpr int RING_OFF = 0, LDSX_OFF = 131072;
constexpr int LX_MISC = LDSX_OFF;
constexpr int LX_TSTART = LDSX_OFF + 128;
constexpr int LX_CNT = LDSX_OFF + 384;
constexpr int LX_TOKOFF = LDSX_OFF + 1024;
constexpr int LX_DEST = LDSX_OFF + 6144;
constexpr int LX_GW = LDSX_OFF + 11264;
static_assert(LX_GW + 5120 <= LDS_BYTES, "LDS map");

__device__ __forceinline__ void tr64_item(const float* src, int N, int k0, int n0, bf16_t* dst, int ldk, int dstrow0, LAS unsigned* tt, int lane) {
    const int nc = lane & 15, kp = lane >> 4;
    const float* sp = src + (size_t)(k0 + 2 * kp) * N + n0 + 4 * nc;
    f32x4 a[8], b[8];
#pragma unroll
    for (int i = 0; i < 8; ++i) { a[i] = *(const f32x4*)(sp + (size_t)(8 * i) * N); b[i] = *(const f32x4*)(sp + (size_t)(8 * i + 1) * N); }
#pragma unroll
    for (int i = 0; i < 8; ++i)
#pragma unroll
        for (int q = 0; q < 4; ++q) { const int n = 4 * nc + q; tt[n * 32 + ((kp + 4 * i) ^ ((nc & 7) << 2))] = cvt_pk_bf16(a[i][q], b[i][q]); }
    asm volatile("s_waitcnt lgkmcnt(0)" ::: "memory");
    const int c = lane & 7;
#pragma unroll
    for (int j = 0; j < 8; ++j) { const int n = (lane >> 3) + 8 * j;
        const u32x4 o = *(const LAS u32x4*)(tt + n * 32 + ((c ^ ((n >> 2) & 7)) << 2));
        *(u32x4*)(dst + (size_t)(dstrow0 + n) * ldk + k0 + 8 * c) = o; }
    asm volatile("s_waitcnt lgkmcnt(0)" ::: "memory");
}
__device__ __forceinline__ void convert_dense(Frame& F, const Args& A) {
    LAS unsigned* tt = (LAS unsigned*)(F.lds + RING_OFF + F.wave * 8192);
    for (int it = F.gw; it < 3200; it += F.NGW) {
        int r = it;
        if (r < 1536) { const int j = r / 768; r %= 768; tr64_item(A.in[1] + (size_t)j * D * QKVW, QKVW, (r / 48) * 64, (r % 48) * 64, (bf16_t*)(F.ws + WS_WQKV) + (size_t)j * QKVW * D, D, (r % 48) * 64, tt, F.lane); continue; } r -= 1536;
        if (r < 512) { const int j = r / 256; r %= 256; tr64_item(A.in[2] + (size_t)j * D * D, D, (r / 16) * 64, (r % 16) * 64, (bf16_t*)(F.ws + WS_WO) + (size_t)j * D * D, D, (r % 16) * 64, tt, F.lane); continue; } r -= 512;
        if (r < 512) { const int j = r / 256; r %= 256; tr64_item(A.in[8] + (size_t)j * D * D, D, (r / 16) * 64, (r % 16) * 64, (bf16_t*)(F.ws + WS_WIN) + (size_t)j * D * D, D, (r % 16) * 64, tt, F.lane); continue; } r -= 512;
        if (r < 512) { const int j = r / 256; r %= 256; tr64_item(A.in[11] + (size_t)j * D * D, D, (r / 16) * 64, (r % 16) * 64, (bf16_t*)(F.ws + WS_WOUT) + (size_t)j * D * D, D, (r % 16) * 64, tt, F.lane); continue; } r -= 512;
        { const int jg = r / 16; r %= 16;
          tr64_item(A.in[9] + (size_t)jg * 65536, 256, (r / 4) * 64, (r % 4) * 64, (bf16_t*)(F.ws + WS_WGRP) + (size_t)jg * 65536, 256, (r % 4) * 64, tt, F.lane); }
    }
    bf16_t* WRH = (bf16_t*)(F.ws + WS_RTW); bf16_t* WRL = WRH + DEPTH * 48 * D;
    for (int i = F.bx * 512 + F.tid; i < DEPTH * 48 * D; i += F.G * 512) {
        const int k = i & (D - 1), jc = (i >> 10) % 48, l = (i >> 10) / 48;
        const float w = jc < NG ? A.in[14][((size_t)l * D + k) * NG + jc] : (jc < NG + NE ? A.in[16][((size_t)l * D + k) * NE + jc - NG] : 0.f);
        const unsigned h = f2bf(w); WRH[i] = (bf16_t)h; WRL[i] = (bf16_t)f2bf(w - __uint_as_float(h << 16));
    }
}
__device__ __forceinline__ void convert_moe(Frame& F, const Args& A, int layer, int it0, int stride, int it_end = 12288) {
    LAS unsigned* tt = (LAS unsigned*)(F.lds + RING_OFF + F.wave * 8192);
    bf16_t* WGU = (bf16_t*)(F.ws + ((layer & 1) ? WS_WGU2 : WS_WGU)); bf16_t* WD = (bf16_t*)(F.ws + ((layer & 1) ? WS_WD2 : WS_WD));
    for (int it = it0; it < it_end; it += stride) {
        int r = it;
        if (r < 8192) { const int up = r >= 4096; r &= 4095; const int e = r >> 7; r &= 127; const int n0 = (r & 7) * 64;
            tr64_item((up ? A.in[19] : A.in[18]) + ((size_t)layer * NE + e) * D * DE, DE, (r >> 3) * 64, n0, WGU + (size_t)e * 1024 * D, D, (n0 >> 7) * 256 + (n0 & 127) + up * 128, tt, F.lane); continue; }
        r -= 8192; { const int e = r >> 7; r &= 127;
            tr64_item(A.in[20] + ((size_t)layer * NE + e) * DE * D, D, (r >> 4) * 64, (r & 15) * 64, WD + (size_t)e * D * DE, DE, (r & 15) * 64, tt, F.lane); }
    }
}
__device__ __forceinline__ pg8::MoeOrder moe_prepare(Frame& F, int layer, int vcu, bool build) {
    LAS int* tstart = (LAS int*)(F.lds + LX_TSTART); LAS int* cntl = (LAS int*)(F.lds + LX_CNT); LAS int* misc = (LAS int*)(F.lds + LX_MISC);
    LAS unsigned* tokoff = (LAS unsigned*)(F.lds + LX_TOKOFF); LAS int* destl = (LAS int*)(F.lds + LX_DEST); LAS float* gwl = (LAS float*)(F.lds + LX_GW);
    const unsigned* cnt = F.ctl + CW_CNT + layer * NE * 16; const int* LTOK = (const int*)(F.ws + WS_LTOK); const float* GATEW = (const float*)(F.ws + WS_GATEW);
    if (build) {
        if (F.wave == 0) {
            const int c = F.lane < NE ? (int)cnt[F.lane * 16] : 0; int inc = (c + 255) >> 8;
#pragma unroll
            for (int o = 1; o < 32; o <<= 1) { const int v = __shfl_up(inc, o); if ((F.lane & 31) >= o) inc += v; }
            if (F.lane < NE) { tstart[F.lane] = inc - ((c + 255) >> 8); cntl[F.lane] = c; if (F.lane == NE - 1) { tstart[NE] = inc; misc[16] = inc; } }
        }
        __syncthreads();
    }
    pg8::MoeOrder S; S.tstart = tstart; S.cntl = cntl; S.tokoff = tokoff; S.ue = misc + 20; S.ntiles = misc[16]; S.G = F.G; S.c = vcu; S.ilo = 0; S.ihi = 1 << 20;
    if (build) {
        for (int k = F.tid; k < 5 * 256; k += NWAVES * 64) { const int i = k >> 8, r = k & 255; pg8::Unit u;
            if (S.find(i, u)) { if (r == 0) misc[20 + i] = u.e; const int p = u.pos0 + r; const int dest = p < u.cnt ? LTOK[(size_t)u.e * LIST_CAP + p] : -1;
                tokoff[k] = dest < 0 ? 0u : (unsigned)(dest >> 1) * (unsigned)(D * 2); destl[k] = dest; gwl[k] = dest < 0 ? 0.f : GATEW[dest]; } }
        __syncthreads();
    }
    return S;
}

__device__ __forceinline__ void phase_prologue(Frame& F, const Args& A) {
    const float* x = A.in[0]; bf16_t* HB = (bf16_t*)(F.ws + WS_HB);
    const size_t n8 = (size_t)NTOK * D / 8;
    for (size_t i = (size_t)F.bx * 512 + F.tid; i < n8; i += (size_t)F.G * 512) {
        const f32x4 a = *(const f32x4*)(x + i * 8), b = *(const f32x4*)(x + i * 8 + 4);
        u32x4 o; o.x = pk2(a.x, a.y); o.y = pk2(a.z, a.w); o.z = pk2(b.x, b.y); o.w = pk2(b.z, b.w);
        *(u32x4*)(HB + i * 8) = o;
    }
    float* rc = (float*)(F.ws + WS_ROPE); float* rs = rc + SEQ * 8;
    for (int i = F.bx * 512 + F.tid; i < SEQ * 8; i += F.G * 512) {
        const int pos = i >> 3, fi = i & 7;
        const float inv = (float)exp2(-(double)fi * (1.0 / 8.0) * 18.931568569324174);
        const float ang = (float)pos * inv;
        const double rev = (double)ang * 0.15915494309189535; const float fr = (float)(rev - floor(rev));
        rc[i] = __builtin_amdgcn_cosf(fr); rs[i] = __builtin_amdgcn_sinf(fr);
    }
    if (F.bx == 0 && F.tid < 2) {
        const int j = F.tid; float s1 = 0.f, s2 = 0.f;
        for (int i = 0; i < HD; ++i) { s1 += A.in[3][j * HD + i] * A.in[4][j * HD + i]; s2 += A.in[5][j * HD + i] * A.in[6][j * HD + i]; }
        const float li = j == 0 ? 0.2f : 0.47071301834358416f;
        ((float*)F.ctl)[CW_LAM + j] = expf(s1) - expf(s2) + li;
    }
}

__device__ __forceinline__ void unpack8(const u32x4 v, float (&f)[8]) {
    f[0] = __uint_as_float(v.x << 16); f[1] = __uint_as_float(v.x & 0xffff0000u); f[2] = __uint_as_float(v.y << 16); f[3] = __uint_as_float(v.y & 0xffff0000u);
    f[4] = __uint_as_float(v.z << 16); f[5] = __uint_as_float(v.z & 0xffff0000u); f[6] = __uint_as_float(v.w << 16); f[7] = __uint_as_float(v.w & 0xffff0000u);
}
template <int W> __device__ __forceinline__ void pool_block(const bf16_t* U, bf16_t* PB, int row0, int col) {
    const int pos0 = row0 & (SEQ - 1);
    u32x4 v[16 + W - 1];
#pragma unroll
    for (int i = 0; i < 16 + W - 1; ++i) { const int back = W - 1 - i; const int r = (back > 0 && pos0 - back < 0) ? row0 : row0 - back; v[i] = *(const u32x4*)(U + (size_t)r * D + col); }
    float s[8];
#pragma unroll
    for (int j = 0; j < 8; ++j) s[j] = 0.f;
#pragma unroll
    for (int t = 0; t < W; ++t) { float f[8]; unpack8(v[W - 1 - t], f); const float m = (t <= pos0) ? 1.f : 0.f;
#pragma unroll
        for (int j = 0; j < 8; ++j) s[j] += m * f[j]; }
#pragma unroll
    for (int o = 0; o < 16; ++o) {
        float c[8]; unpack8(v[W - 1 + o], c);
        if (o > 0) { float lv[8]; unpack8(v[o - 1], lv); const float m = (pos0 + o - W >= 0) ? 1.f : 0.f;
#pragma unroll
            for (int j = 0; j < 8; ++j) s[j] += c[j] - m * lv[j]; }
        const int pos = pos0 + o; const float inv = 1.f / (float)((pos + 1 < W) ? pos + 1 : W);
        u32x4 ov; ov.x = cvt_pk_bf16(s[0] * inv - c[0], s[1] * inv - c[1]); ov.y = cvt_pk_bf16(s[2] * inv - c[2], s[3] * inv - c[3]);
        ov.z = cvt_pk_bf16(s[4] * inv - c[4], s[5] * inv - c[5]); ov.w = cvt_pk_bf16(s[6] * inv - c[6], s[7] * inv - c[7]);
        *(u32x4*)(PB + (size_t)(row0 + o) * D + col) = ov;
    }
}
__device__ __forceinline__ void phase_pool(Frame& F) {
    const bf16_t* U = (const bf16_t*)(F.ws + WS_Q); bf16_t* PB = (bf16_t*)(F.ws + WS_K);
    for (int it = F.gw; it < 4 * (NTOK / 32); it += F.NGW) {
        const int g = it & 3, rb = (it >> 2) * 2 + (F.lane >> 5), row0 = rb * 16, col = g * 256 + (F.lane & 31) * 8;
        if (g == 0) pool_block<2>(U, PB, row0, col); else if (g == 1) pool_block<4>(U, PB, row0, col); else if (g == 2) pool_block<8>(U, PB, row0, col); else pool_block<16>(U, PB, row0, col);
    }
}

__device__ __forceinline__ void ln_row(f32x4 (&v)[4], const f32x4 (&gg)[4], const f32x4 (&bb)[4]) {
    float s = 0.f;
#pragma unroll
    for (int j = 0; j < 4; ++j) s += (v[j].x + v[j].y) + (v[j].z + v[j].w);
    const float mean = wave_sum(s) * (1.f / D); float s2 = 0.f;
#pragma unroll
    for (int j = 0; j < 4; ++j) { v[j] = v[j] - mean; s2 += (v[j].x * v[j].x + v[j].y * v[j].y) + (v[j].z * v[j].z + v[j].w * v[j].w); }
    const float rstd = 1.0f / sqrtf(wave_sum(s2) * (1.f / D) + LN_EPS);
#pragma unroll
    for (int j = 0; j < 4; ++j) v[j] = v[j] * rstd * gg[j] + bb[j];
}

__device__ __forceinline__ void phase_route(Frame& F, const Args& A, int layer) {
    typedef short bf16x8 __attribute__((ext_vector_type(8)));
    const bf16_t* T = (const bf16_t*)(F.ws + WS_T); bf16_t* HB = (bf16_t*)(F.ws + WS_HB);
    const float* g = A.in[12] + (size_t)(layer * 2) * D; const float* b = A.in[13] + (size_t)(layer * 2) * D;
    const float* bg = A.in[15] + layer * NG; const float* be = A.in[17] + layer * NE;
    const bf16_t* WRH = (const bf16_t*)(F.ws + WS_RTW) + (size_t)layer * 48 * D; const bf16_t* WRL = WRH + DEPTH * 48 * D;
    unsigned* cnt = F.ctl + CW_CNT + layer * NE * 16; int* LTOK = (int*)(F.ws + WS_LTOK); float* GATEW = (float*)(F.ws + WS_GATEW);
    constexpr int RW_PITCH = 1040, RW_HL = 36 * RW_PITCH, LG_OFF = 81920, GB_OFF = 114688;
    LAS unsigned char* rw = F.lds + RING_OFF;
    LAS float* gl = (LAS float*)(F.lds + RING_OFF + GB_OFF); LAS float* bl_ = gl + D;
    LAS unsigned* lcnt = (LAS unsigned*)(F.lds + RING_OFF + GB_OFF + 8192); LAS unsigned* lbase = lcnt + NE;
    if (F.tid < NE) lcnt[F.tid] = 0u;
    for (int i = F.tid; i < D / 4; i += NWAVES * 64) { *(LAS f32x4*)(gl + 4 * i) = *(const f32x4*)(g + 4 * i); *(LAS f32x4*)(bl_ + 4 * i) = *(const f32x4*)(b + 4 * i); }
    LAS float* lg = (LAS float*)(F.lds + RING_OFF + LG_OFF + F.wave * 4096);
    const int r16 = F.lane & 15, kq = F.lane >> 4;
    for (int g0 = F.bx * NWAVES; g0 < NTOK / 16; g0 += F.G * NWAVES) {
        const int grp = g0 + F.wave, row = grp * 16 + r16;
        const bf16_t* trow = T + (size_t)row * D + 8 * kq; bf16_t* hbrow = HB + (size_t)row * D + 8 * kq;
        float sum = 0.f, ss = 0.f;
        { const float* st = (const float*)(F.ws + WS_STATS) + ((size_t)row * 16 + 4 * kq) * 2;
          const f32x4 p0 = *(const f32x4*)st, p1 = *(const f32x4*)(st + 4); sum = (p0.x + p0.z) + (p1.x + p1.z); ss = (p0.y + p0.w) + (p1.y + p1.w); }
        sum += __shfl_xor(sum, 16); sum += __shfl_xor(sum, 32); ss += __shfl_xor(ss, 16); ss += __shfl_xor(ss, 32);
        const float mean = sum * (1.f / D), var = fmaxf(ss * (1.f / D) - mean * mean, 0.f), rstd = 1.0f / sqrtf(var + LN_EPS);
        f32x4 acc[3];
#pragma unroll
        for (int q = 0; q < 3; ++q) acc[q] = (f32x4){0.f, 0.f, 0.f, 0.f};
        int co[3];
#pragma unroll
        for (int q = 0; q < 3; ++q) { const int c = 16 * q + r16; co[q] = (c < 36 ? c : 35) * RW_PITCH + kq * 16; }
        for (int half = 0; half < 2; ++half) {
            u32x4 twv[16];
#pragma unroll
            for (int s2 = 0; s2 < 16; ++s2) twv[s2] = *(const __attribute__((address_space(1))) u32x4*)(trow + 32 * (half * 16 + s2));
            __syncthreads();
            {
                u32x4 wv[9];
#pragma unroll
                for (int j = 0; j < 9; ++j) { const int p = F.tid + j * (NWAVES * 64); const int hl = p / 2304, rem = p - hl * 2304, c = rem >> 6, c16 = rem & 63;
                    wv[j] = *(const __attribute__((address_space(1))) u32x4*)((hl ? WRL : WRH) + (size_t)c * D + half * 512 + c16 * 8); }
#pragma unroll
                for (int j = 0; j < 9; ++j) { const int p = F.tid + j * (NWAVES * 64); const int hl = p / 2304, rem = p - hl * 2304, c = rem >> 6, c16 = rem & 63;
                    *(LAS u32x4*)(rw + hl * RW_HL + c * RW_PITCH + c16 * 16) = wv[j]; }
            }
            __syncthreads();
#pragma unroll
            for (int s2 = 0; s2 < 16; ++s2) { const int s = half * 16 + s2;
                const u32x4 tw = twv[s2];
                const f32x4 x0 = (f32x4){__uint_as_float(tw.x << 16), __uint_as_float(tw.x & 0xffff0000u), __uint_as_float(tw.y << 16), __uint_as_float(tw.y & 0xffff0000u)};
                const f32x4 x1 = (f32x4){__uint_as_float(tw.z << 16), __uint_as_float(tw.z & 0xffff0000u), __uint_as_float(tw.w << 16), __uint_as_float(tw.w & 0xffff0000u)};
                const f32x4 g0 = *(const LAS f32x4*)(gl + 32 * s + 8 * kq), g1 = *(const LAS f32x4*)(gl + 32 * s + 8 * kq + 4), b0 = *(const LAS f32x4*)(bl_ + 32 * s + 8 * kq), b1 = *(const LAS f32x4*)(bl_ + 32 * s + 8 * kq + 4);
                const f32x4 y0 = (x0 - mean) * rstd * g0 + b0, y1 = (x1 - mean) * rstd * g1 + b1;
                u32x4 hw; hw.x = cvt_pk_bf16(y0.x, y0.y); hw.y = cvt_pk_bf16(y0.z, y0.w); hw.z = cvt_pk_bf16(y1.x, y1.y); hw.w = cvt_pk_bf16(y1.z, y1.w);
                *(__attribute__((address_space(1))) u32x4*)(hbrow + 32 * s) = hw;
                u32x4 lw;
                lw.x = cvt_pk_bf16(y0.x - __uint_as_float(hw.x << 16), y0.y - __uint_as_float(hw.x & 0xffff0000u)); lw.y = cvt_pk_bf16(y0.z - __uint_as_float(hw.y << 16), y0.w - __uint_as_float(hw.y & 0xffff0000u));
                lw.z = cvt_pk_bf16(y1.x - __uint_as_float(hw.z << 16), y1.y - __uint_as_float(hw.z & 0xffff0000u)); lw.w = cvt_pk_bf16(y1.z - __uint_as_float(hw.w << 16), y1.w - __uint_as_float(hw.w & 0xffff0000u));
                const bf16x8 ah = __builtin_bit_cast(bf16x8, hw), al = __builtin_bit_cast(bf16x8, lw);
                bf16x8 bhv[3], blv[3];
#pragma unroll
                for (int q = 0; q < 3; ++q) { bhv[q] = *(const LAS bf16x8*)(rw + co[q] + s2 * 64); blv[q] = *(const LAS bf16x8*)(rw + RW_HL + co[q] + s2 * 64); }
                __builtin_amdgcn_s_setprio(1);
#pragma unroll
                for (int q = 0; q < 3; ++q) {
                    acc[q] = __builtin_amdgcn_mfma_f32_16x16x32_bf16(ah, bhv[q], acc[q], 0, 0, 0);
                    acc[q] = __builtin_amdgcn_mfma_f32_16x16x32_bf16(ah, blv[q], acc[q], 0, 0, 0);
                    acc[q] = __builtin_amdgcn_mfma_f32_16x16x32_bf16(al, bhv[q], acc[q], 0, 0, 0);
                }
                __builtin_amdgcn_s_setprio(0);
            }
        }
#pragma unroll
        for (int q = 0; q < 3; ++q)
#pragma unroll
            for (int r = 0; r < 4; ++r) lg[(4 * kq + r) * 48 + 16 * q + r16] = acc[q][r];
        asm volatile("s_waitcnt lgkmcnt(0)" ::: "memory");
        int ea = 0, eb = 0; unsigned pa = 0u, pb = 0u;
        if (F.lane < 16) {
            const LAS float* L = lg + F.lane * 48; const int tok = grp * 16 + F.lane;
            float l4[4];
#pragma unroll
            for (int i = 0; i < 4; ++i) l4[i] = L[i] + bg[i];
            int gi = 0; float gm = l4[0];
#pragma unroll
            for (int i = 1; i < 4; ++i) if (l4[i] > gm) { gm = l4[i]; gi = i; }
            float gs = 0.f;
#pragma unroll
            for (int i = 0; i < 4; ++i) gs += expf(l4[i] - gm);
            const float gp = 1.f / gs;
            float ein[8];
#pragma unroll
            for (int j = 0; j < 8; ++j) ein[j] = L[NG + gi * EPG + j] + be[gi * EPG + j];
            int i0 = 0; float v0 = ein[0];
#pragma unroll
            for (int j = 1; j < 8; ++j) if (ein[j] > v0) { v0 = ein[j]; i0 = j; }
            int i1 = -1; float v1 = -INFINITY;
#pragma unroll
            for (int j = 0; j < 8; ++j) if (j != i0 && ein[j] > v1) { v1 = ein[j]; i1 = j; }
            const float e1 = expf(v1 - v0), s0 = 1.f / (1.f + e1), s1 = e1 / (1.f + e1);
            ea = gi * EPG + i0; eb = gi * EPG + i1;
            pa = __hip_atomic_fetch_add(lcnt + ea, 1u, __ATOMIC_RELAXED, __HIP_MEMORY_SCOPE_WORKGROUP); pb = __hip_atomic_fetch_add(lcnt + eb, 1u, __ATOMIC_RELAXED, __HIP_MEMORY_SCOPE_WORKGROUP);
            *(float2*)(GATEW + tok * 2) = make_float2(gp * s0, gp * s1);
        }
        __syncthreads();
        if (F.tid < NE) { const unsigned n = lcnt[F.tid]; lbase[F.tid] = n ? atomicAdd(cnt + F.tid * 16, n) : 0u; }
        __syncthreads();
        if (F.lane < 16) { const int tok = grp * 16 + F.lane;
            LTOK[(size_t)ea * LIST_CAP + lbase[ea] + pa] = tok * 2; LTOK[(size_t)eb * LIST_CAP + lbase[eb] + pb] = tok * 2 + 1; }
        __syncthreads();
        if (F.tid < NE) lcnt[F.tid] = 0u;
    }
    __syncthreads();
}

__device__ __forceinline__ void bf8_to_f(const u32x4 w, f32x4& a, f32x4& b) {
    a = (f32x4){__uint_as_float(w.x << 16), __uint_as_float(w.x & 0xffff0000u), __uint_as_float(w.y << 16), __uint_as_float(w.y & 0xffff0000u)};
    b = (f32x4){__uint_as_float(w.z << 16), __uint_as_float(w.z & 0xffff0000u), __uint_as_float(w.w << 16), __uint_as_float(w.w & 0xffff0000u)};
}
__device__ __forceinline__ void phase_ln2(Frame& F, const Args& A, int layer) {
    bf16_t* HB = (bf16_t*)(F.ws + WS_HB); const bf16_t* Y = (const bf16_t*)(F.ws + WS_Y);
    const float* g = A.in[12] + (size_t)(layer * 2 + 1) * D; const float* b = A.in[13] + (size_t)(layer * 2 + 1) * D;
    const bool last = layer == DEPTH - 1;
    f32x4 gg[4], bb[4];
#pragma unroll
    for (int j = 0; j < 2; ++j) { const int c = 512 * j + 8 * F.lane; gg[2 * j] = *(const f32x4*)(g + c); gg[2 * j + 1] = *(const f32x4*)(g + c + 4); bb[2 * j] = *(const f32x4*)(b + c); bb[2 * j + 1] = *(const f32x4*)(b + c + 4); }
    for (int row = F.gw; row < NTOK; row += F.NGW) {
        f32x4 v[4];
#pragma unroll
        for (int j = 0; j < 2; ++j) { const int c = 512 * j + 8 * F.lane;
            const u32x4 hw = *(const u32x4*)(HB + (size_t)row * D + c), y0 = *(const u32x4*)(Y + (size_t)(2 * row) * D + c), y1 = *(const u32x4*)(Y + (size_t)(2 * row + 1) * D + c);
            f32x4 h0, h1, a0, a1, c0, c1; bf8_to_f(hw, h0, h1); bf8_to_f(y0, a0, a1); bf8_to_f(y1, c0, c1);
            v[2 * j] = h0 * ALPHA + (a0 + c0); v[2 * j + 1] = h1 * ALPHA + (a1 + c1); }
        ln_row(v, gg, bb);
        if (last) {
#pragma unroll
            for (int j = 0; j < 2; ++j) { float* o = F.out + (size_t)row * D + 512 * j + 8 * F.lane; *(f32x4*)o = v[2 * j]; *(f32x4*)(o + 4) = v[2 * j + 1]; }
        } else {
#pragma unroll
            for (int j = 0; j < 2; ++j) { u32x4 o; o.x = cvt_pk_bf16(v[2 * j].x, v[2 * j].y); o.y = cvt_pk_bf16(v[2 * j].z, v[2 * j].w); o.z = cvt_pk_bf16(v[2 * j + 1].x, v[2 * j + 1].y); o.w = cvt_pk_bf16(v[2 * j + 1].z, v[2 * j + 1].w);
                *(u32x4*)(HB + (size_t)row * D + 512 * j + 8 * F.lane) = o; }
        }
    }
}

__device__ __forceinline__ int lane_id_fresh() { int l; asm volatile("v_mbcnt_lo_u32_b32 %0, -1, 0\n\tv_mbcnt_hi_u32_b32 %0, -1, %0" : "=v"(l)); return l; }
__device__ __forceinline__ Frame make_frame(const Args& args, unsigned char* lds, int wave0) {
    Frame F; int wv = wave0; asm volatile("" : "+s"(wv));
    const int ln = lane_id_fresh();
    const int tid = wv * 64 + ln;
    unsigned char* ws = args.ws; asm volatile("" : "+s"(ws));
    F.lds = (LAS unsigned char*)lds; F.tid = tid; F.lane = ln; F.wave = wv;
    int bx = blockIdx.x, G = gridDim.x; asm volatile("" : "+s"(bx), "+s"(G));
    F.bx = bx; F.G = G; F.gw = bx * NWAVES + F.wave; F.NGW = G * NWAVES;
    F.vcu = (G % 8 == 0) ? (bx % 8) * (G / 8) + bx / 8 : bx;
    F.ws = ws; F.out = args.out; F.ctl = (unsigned*)(ws + WS_CTL);
    return F;
}
__device__ __forceinline__ bool in_range(int lo, int hi, int k) { asm volatile("" : "+s"(lo), "+s"(hi), "+s"(k)); return lo <= k && k < hi; }
__global__ void __launch_bounds__(NWAVES * 64, 2) mk_fwd(Args args) {
    extern __shared__ __attribute__((aligned(16))) unsigned char lds[];
    const int wave0 = __builtin_amdgcn_readfirstlane((int)threadIdx.x >> 6);
    for (int u = threadIdx.x; u < (LDS_BYTES - LDSX_OFF) / 4; u += NWAVES * 64) ((LAS unsigned*)((LAS unsigned char*)lds + LDSX_OFF))[u] = 0u;
    __syncthreads();
    const int lo = args.ph_lo, hi = args.ph_hi;
    unsigned* const barw = (unsigned*)(args.ws + WS_CTL) + CW_BAR;
    XcdBarrier bar; bar.bar = barw; bar.x = 0; bar.st = nullptr;
    if (hi - lo > 1) bar = xcd_barrier_post(barw, (volatile LAS unsigned*)((LAS unsigned char*)lds + LX_MISC) + 8, threadIdx.x == 0);
#define IN(k) in_range(lo, hi, (k))
#define SEAM(k) do { if ((k) + 1 < hi) { XcdBarrier bb_ = bar; asm volatile("" : "+s"(bb_.bar));     \
        xcd_barrier(bb_, wave0 == 0 && lane_id_fresh() == 0); } } while (0)
    if (IN(0)) { Frame F = make_frame(args, lds, wave0); phase_prologue(F, args); convert_dense(F, args); SEAM(0); }
    for (int l = 0; l < DEPTH; ++l) {
        const int base = 1 + 8 * l, j = l >> 1; const bool attn = !(l & 1);
        if (IN(base)) {
            Frame F = make_frame(args, lds, wave0); const bf16_t* HB = (const bf16_t*)(F.ws + WS_HB); bf16_t* QB = (bf16_t*)(F.ws + WS_Q);
            if (attn) {
                pg8::Gemm g{HB, (const bf16_t*)(F.ws + WS_WQKV) + (size_t)j * QKVW * D, D, D, D, 0}; pg8::StaticOrder S; S.init(NTOK, QKVW, F.G, F.bx);
                pg8::EpiQKV E{QB, (const float*)(F.ws + WS_ROPE), (const float*)(F.ws + WS_ROPE) + SEQ * 8};
                pg8::gemm_phase<pg8::EpiQKV, pg8::StaticOrder, true, false>(F.lds + RING_OFF, g, S, E, F.tid);
            } else {
                pg8::Gemm g{HB, (const bf16_t*)(F.ws + WS_WIN) + (size_t)j * D * D, D, D, D, 0}; pg8::StaticOrder S; S.init(NTOK, D, F.G, F.bx);
                pg8::EpiBf16S E{QB, nullptr};
                pg8::gemm_phase<pg8::EpiBf16S, pg8::StaticOrder, true, false>(F.lds + RING_OFF, g, S, E, F.tid);
            }
            SEAM(base);
        }
        if (IN(base + 1)) {
            if (attn) {
                Frame F = make_frame(args, lds, wave0);
                att::Tensors T{(const bf16_t*)(F.ws + WS_Q), (const bf16_t*)(F.ws + WS_K), (const bf16_t*)(F.ws + WS_V), (bf16_t*)(F.ws + WS_O), (float*)(F.ws + WS_O0S), args.in[7] + j * VD,
                               ((const float*)F.ctl)[CW_LAM + j], 1.0f - (j == 0 ? 0.2f : 0.47071301834358416f)};
                att::attn_phase(F.lds + RING_OFF, T, F.G, F.vcu, F.bx, F.tid);
            } else { Frame F = make_frame(args, lds, wave0); phase_pool(F); }
            SEAM(base + 1);
        }
        if (IN(base + 2)) {
            if (!attn) {
                Frame F = make_frame(args, lds, wave0);
                pg8::Gemm g{(const bf16_t*)(F.ws + WS_K), (const bf16_t*)(F.ws + WS_WGRP) + (size_t)j * 4 * 65536, D, 256, 256, 256}; pg8::StaticOrder S; S.init(NTOK, D, F.G, F.bx);
                pg8::EpiBf16S E{(bf16_t*)(F.ws + WS_V), args.in[10] + j * D};
                pg8::gemm_phase<pg8::EpiBf16S, pg8::StaticOrder, true, false>(F.lds + RING_OFF, g, S, E, F.tid);
                SEAM(base + 2);
            }
        }
        if (IN(base + 3)) {
            Frame F = make_frame(args, lds, wave0);
            const size_t aoffb = attn ? WS_O : WS_V, woffb = (attn ? WS_WO : WS_WOUT) + (size_t)j * D * D * 2;
            pg8::Gemm g{(const bf16_t*)(F.ws + aoffb), (const bf16_t*)(F.ws + woffb), D, D, D, 0}; pg8::StaticOrder S; S.init(NTOK, D, F.G, F.bx);
            pg8::EpiResid E{l == 0 ? args.in[0] : nullptr, (const bf16_t*)(F.ws + WS_HB), (bf16_t*)(F.ws + WS_T), (float*)(F.ws + WS_STATS)};
            pg8::gemm_phase<pg8::EpiResid, pg8::StaticOrder, true, false>(F.lds + RING_OFF, g, S, E, F.tid);
            SEAM(base + 3);
        }
        if (IN(base + 4)) { Frame F = make_frame(args, lds, wave0); phase_route(F, args, l); if (l == 0) convert_moe(F, args, 0, F.gw, F.NGW);     SEAM(base + 4); }
        if (IN(base + 5)) {
            int nparts = 2; asm volatile("" : "+s"(nparts));
            for (int part = 0; part < nparts; ++part) {
                Frame F = make_frame(args, lds, wave0);
                pg8::MoeOrder S = moe_prepare(F, l, F.vcu, part == 0);
                const int total = S.ntiles * 4, rem = total % F.G, nmax = (total + F.G - 1) / F.G, nidle = rem ? F.G - rem : F.G, rank = rem ? F.vcu - rem : F.vcu;
                const bool conv = (l + 1 < DEPTH) && rank >= 0; const int kpos = conv ? rank % nmax : (1 << 20);
                S.ilo = part ? kpos : 0; S.ihi = part ? (1 << 20) : kpos;
                pg8::Gemm g{(const bf16_t*)(F.ws + WS_HB), (const bf16_t*)(F.ws + ((l & 1) ? WS_WGU2 : WS_WGU)), D, D, D, 0};
                pg8::EpiSwiGLU E{(bf16_t*)(F.ws + WS_ACT)};
                pg8::gemm_phase<pg8::EpiSwiGLU, pg8::MoeOrder, true, true>(F.lds + RING_OFF, g, S, E, F.tid);
                if (part == 0 && conv) { convert_moe(F, args, l + 1, rank * NWAVES + F.wave, nidle * NWAVES, 8192); __syncthreads(); }
            }
            SEAM(base + 5);
        }
        if (IN(base + 6)) {
            int nparts = 2; asm volatile("" : "+s"(nparts));
            for (int part = 0; part < nparts; ++part) {
                Frame F = make_frame(args, lds, wave0);
                pg8::MoeOrder S = moe_prepare(F, l, F.vcu, false);
                const int total = S.ntiles * 4, rem = total % F.G, nmax = (total + F.G - 1) / F.G, nidle = rem ? F.G - rem : F.G, rank = rem ? F.vcu - rem : F.vcu;
                const bool conv = (l + 1 < DEPTH) && rank >= 0; const int kpos = conv ? rank % nmax : (1 << 20);
                S.ilo = part ? kpos : 0; S.ihi = part ? (1 << 20) : kpos;
                pg8::Gemm g{(const bf16_t*)(F.ws + WS_ACT), (const bf16_t*)(F.ws + ((l & 1) ? WS_WD2 : WS_WD)), DE, DE, DE, 0};
                pg8::EpiScatter E{(bf16_t*)(F.ws + WS_Y), (const LAS int*)(F.lds + LX_DEST), (const LAS float*)(F.lds + LX_GW)};
                pg8::gemm_phase<pg8::EpiScatter, pg8::MoeOrder, true, false>(F.lds + RING_OFF, g, S, E, F.tid);
                if (part == 0 && conv) { convert_moe(F, args, l + 1, 8192 + rank * NWAVES + F.wave, nidle * NWAVES, 12288); __syncthreads(); }
            }
            SEAM(base + 6);
        }
        if (IN(base + 7)) { Frame F = make_frame(args, lds, wave0); phase_ln2(F, args, l); SEAM(base + 7); }
    }
#undef IN
#undef SEAM
}

extern "C" void kernel_launch(void* const* d_in, const int* in_sizes, int n_in, void* d_out, int out_size, void* d_ws, size_t ws_size, hipStream_t stream) {
    static int grid = 0;
    if (grid == 0) {
        if (n_in != 21 || out_size != NTOK * D || ws_size < WS_END) { fprintf(stderr, "kernel_launch: unexpected shapes (n_in %d out %d ws %zu); nothing launched\n", n_in, out_size, ws_size); grid = -1; return; }
        int dev = 0, cus = 0;
        if (hipGetDevice(&dev) != hipSuccess || hipDeviceGetAttribute(&cus, hipDeviceAttributeMultiprocessorCount, dev) != hipSuccess) { grid = -1; return; }
        if (hipFuncSetAttribute((const void*)mk_fwd, hipFuncAttributeMaxDynamicSharedMemorySize, LDS_BYTES) != hipSuccess) { grid = -1; return; }
        grid = cus > 0 ? cus : 256;
    }
    if (grid < 0) return;
    unsigned char* ws = (unsigned char*)d_ws;
    if (hipMemsetAsync(ws + WS_CTL, 0, CTL_ZERO_BYTES, stream) != hipSuccess) return;
    Args a{};
    for (int i = 0; i < 21; ++i) a.in[i] = (const float*)d_in[i];
    a.out = (float*)d_out; a.ws = ws; a.ph_lo = 0; a.ph_hi = 1 + 8 * DEPTH;
    hipLaunchKernelGGL(mk_fwd, dim3(grid), dim3(NWAVES * 64), LDS_BYTES, stream, a);
}
```
